# Optimizing an MI355X kernel written in HIP

```python
import math
import jax
import jax.numpy as jnp
from jax import lax
import numpy as np

D_MODEL = 1024
BATCH = 8
SEQ = 4096
DEPTH = 4

CTX_LEN = 256
GRID_W = 64
HEAD_DIM = 64
W_HY = D_MODEL // 4
W_RW = D_MODEL // 4
W_WA = D_MODEL // 4
W_FA = D_MODEL // 4
D_MIX = W_HY + W_RW + W_WA + W_FA
HY_EMB = 33
HY_BANDS = (HY_EMB - 1) // 2
HY_FFN = 64
HY_FAST_DECAY = 0.3
HY_SLOW_DECAY = 1.5
HY_DECAY_TARGET = 1e-2
RW_HEADS = W_RW // HEAD_DIM
RW_LORA_W = 64
RW_LORA_A = 64
RW_GN_EPS = 64e-5
WA_HEADS = W_WA // HEAD_DIM
WA_KV = WA_HEADS // 2
WINDOW = 128
Q_BLOCK = 128
FA_HEADS = W_FA // HEAD_DIM
FA_KV = FA_HEADS // 2
ROPE_THETA = 10000.0
NORM_EPS = 1e-6
NEG_INF = -1e30
SPLITS = (3 * W_HY, W_HY, 3 * W_RW + RW_LORA_W + RW_LORA_A, W_RW,
          W_WA + 2 * WA_KV * HEAD_DIM, W_WA, W_FA + 2 * FA_KV * HEAD_DIM, W_FA)
D_IN = sum(SPLITS)
SPLIT_IDX = tuple(int(i) for i in np.cumsum(SPLITS)[:-1])

kernel_name = 'hymba_style_flow_hybrid_block'


def rms_norm(x, g):
    xf = x.astype(jnp.float32)
    y = xf * lax.rsqrt(jnp.mean(xf * xf, axis=-1, keepdims=True) + NORM_EPS)
    return (y * g.astype(jnp.float32)).astype(x.dtype)


def short_conv(z, w):
    L = z.shape[1]
    zp = jnp.pad(z, ((0, 0), (1, 1), (0, 0)))
    return zp[:, :L] * w[0] + zp[:, 1:L + 1] * w[1] + zp[:, 2:] * w[2]


def heads(t):
    return t.reshape(t.shape[:-1] + (-1, HEAD_DIM))


def group_q(t, n_kv):
    return t.reshape(t.shape[:-1] + (n_kv, -1, HEAD_DIM))


def grid_rope_tables(rows):
    row = jnp.repeat(jnp.arange(rows, dtype=jnp.float32), GRID_W)
    col = jnp.tile(jnp.arange(GRID_W, dtype=jnp.float32), rows)
    n_freq = HEAD_DIM // 4
    inv_freq = ROPE_THETA ** (-jnp.arange(n_freq, dtype=jnp.float32) / n_freq)
    ang = jnp.stack([row[:, None] * inv_freq, col[:, None] * inv_freq], axis=1)
    return jnp.cos(ang), jnp.sin(ang)


def apply_rope(x, cos, sin):
    L = x.shape[1]
    bshape = (1, L) + (1,) * (x.ndim - 3) + cos.shape[1:]
    c = cos.reshape(bshape)
    s = sin.reshape(bshape)
    xr = x.astype(jnp.float32).reshape(x.shape[:-1] + (2, 2, HEAD_DIM // 4))
    xa, xb = xr[..., 0, :], xr[..., 1, :]
    out = jnp.stack([xa * c - xb * s, xb * c + xa * s], axis=-2)
    return out.reshape(x.shape).astype(x.dtype)


def hyena_filters(L, fw1, fb1, freq, fw2, fb2, fw3):
    f32 = lambda a: a.astype(jnp.float32)
    t = jnp.linspace(0.0, 1.0, L, dtype=jnp.float32)[:, None]
    w = (2.0 * math.pi / L) * jnp.arange(L, dtype=jnp.float32)[:, None]
    f = jnp.linspace(1e-4, HY_BANDS - 1, HY_BANDS, dtype=jnp.float32)[None, :]
    z = jnp.concatenate([t, jnp.cos(f * w), jnp.sin(f * w)], axis=-1)
    h = jnp.sin(f32(freq) * (z @ f32(fw1) + f32(fb1)))
    h = jnp.sin(f32(freq) * (h @ f32(fw2) + f32(fb2)))
    h = (h @ f32(fw3)).reshape(L, 2, 2, W_HY)
    max_decay = math.log(HY_DECAY_TARGET) / HY_FAST_DECAY
    min_decay = math.log(HY_DECAY_TARGET) / HY_SLOW_DECAY
    deltas = jnp.linspace(min_decay, max_decay, W_HY, dtype=jnp.float32)
    h = h * jnp.exp(-t * jnp.abs(deltas))[:, None, None, :]
    return h / jnp.sum(jnp.abs(h), axis=(0, 2), keepdims=True)


def two_sided_fftconv(u, h_fwd, h_bwd, bias):
    L = u.shape[1]
    k = jnp.concatenate([h_fwd, jnp.zeros_like(h_fwd[:1]), h_bwd[:0:-1]], axis=0)
    U = jnp.fft.rfft(u, n=2 * L, axis=1)
    K = jnp.fft.rfft(k, n=2 * L, axis=0)
    y = jnp.fft.irfft(U * K[None], n=2 * L, axis=1)[:, :L]
    return y + u * bias


def hyena_branch(z, conv_w, fw1, fb1, freq, fw2, fb2, fw3, bias):
    h = hyena_filters(z.shape[1], fw1, fb1, freq, fw2, fb2, fw3)
    zc = short_conv(z.astype(jnp.float32), conv_w.astype(jnp.float32))
    v, x1, x2 = jnp.split(zc, 3, axis=-1)
    bias = bias.astype(jnp.float32)
    y = x1 * two_sided_fftconv(v, h[:, 0, 0], h[:, 0, 1], bias[0])
    return x2 * two_sided_fftconv(y, h[:, 1, 0], h[:, 1, 1], bias[1])


def rwkv_prep(z, conv_w, w0, w_up, a0, a_up, k_k, k_a):
    z = short_conv(z.astype(jnp.float32), conv_w.astype(jnp.float32))
    r, k, v, w_low, a_low = jnp.split(
        z, [W_RW, 2 * W_RW, 3 * W_RW, 3 * W_RW + RW_LORA_W], axis=-1)
    kk = heads(k * k_k)
    kk = kk / jnp.maximum(jnp.linalg.norm(kk, axis=-1, keepdims=True), 1e-12)
    w_low = jnp.tanh(w_low)
    per_dir = []
    for d in range(2):
        w_log = -jax.nn.softplus(-(w0[d] + w_low @ w_up[d])) - 0.5
        a = jax.nn.sigmoid(a0[d] + a_low @ a_up[d])
        k_d = k * (1.0 + (a - 1.0) * k_a)
        per_dir.append((heads(jnp.exp(-jnp.exp(w_log))), heads(a), heads(k_d)))
    return heads(r), heads(v), kk, per_dir


def rwkv7_scan(s0, r, w, k, v, kk, a, reverse):
    def step(S, inp):
        r_t, w_t, k_t, v_t, kk_t, a_t = inp
        sa = jnp.einsum('bhvk,bhk->bhv', S, -kk_t)
        S = (S * w_t[:, :, None, :] + sa[..., None] * (kk_t * a_t)[:, :, None, :]
             + v_t[..., None] * k_t[:, :, None, :])
        return S, jnp.einsum('bhvk,bhk->bhv', S, r_t)
    xs = tuple(jnp.moveaxis(t, 1, 0) for t in (r, w, k, v, kk, a))
    S, ys = lax.scan(step, s0, xs, reverse=reverse)
    return S, jnp.moveaxis(ys, 0, 1)


def rwkv_readout(y, r, v, k_fwd, k_bwd, r_k, ln_g, ln_b):
    mu = jnp.mean(y, axis=-1, keepdims=True)
    var = jnp.mean(jnp.square(y - mu), axis=-1, keepdims=True)
    yn = ((y - mu) * lax.rsqrt(var + RW_GN_EPS)).reshape(y.shape[:-2] + (-1,)) * ln_g + ln_b
    bonus = jnp.sum(r * (k_fwd + k_bwd) * heads(r_k), axis=-1, keepdims=True) * v
    return yn + bonus.reshape(yn.shape)


def rwkv_mixer(z_ctx, z_lat, conv_w, w0, w_up, a0, a_up, k_k, k_a, r_k, ln_g, ln_b, with_ctx_out):
    rc, vc, kkc, dirs_c = rwkv_prep(z_ctx, conv_w, w0, w_up, a0, a_up, k_k, k_a)
    rl, vl, kkl, dirs_l = rwkv_prep(z_lat, conv_w, w0, w_up, a0, a_up, k_k, k_a)
    s0 = jnp.zeros((z_lat.shape[0], RW_HEADS, HEAD_DIM, HEAD_DIM), jnp.float32)
    ys_c, ys_l = [], []
    for d, reverse in enumerate((False, True)):
        wc, ac, kc = dirs_c[d]
        wl, al, kl = dirs_l[d]
        s_ctx, y_c = rwkv7_scan(s0, rc, wc, kc, vc, kkc, ac, reverse)
        _, y_l = rwkv7_scan(s_ctx, rl, wl, kl, vl, kkl, al, reverse)
        ys_c.append(y_c)
        ys_l.append(y_l)
    out_l = rwkv_readout(ys_l[0] + ys_l[1], rl, vl, dirs_l[0][2], dirs_l[1][2], r_k, ln_g, ln_b)
    if not with_ctx_out:
        return out_l, None
    out_c = rwkv_readout(ys_c[0] + ys_c[1], rc, vc, dirs_c[0][2], dirs_c[1][2], r_k, ln_g, ln_b)
    return out_l, out_c


def full_attention(q, k, v, sink):
    s = jnp.einsum('bqkgd,bskd->bkgqs', q, k, preferred_element_type=jnp.float32) * HEAD_DIM ** -0.5
    if sink is not None:
        B, KV, G, Q, _ = s.shape
        sk = jnp.broadcast_to(sink.astype(jnp.float32).reshape(1, KV, G, 1, 1), (B, KV, G, Q, 1))
        p = jax.nn.softmax(jnp.concatenate([s, sk], axis=-1), axis=-1)[..., :-1]
    else:
        p = jax.nn.softmax(s, axis=-1)
    return jnp.einsum('bkgqs,bskd->bqkgd', p, v.astype(jnp.float32))


def window_attention(q, k, v, kc, vc, sink):
    B, L, KV, G, HD = q.shape
    nb = L // Q_BLOCK
    side = WINDOW // Q_BLOCK
    band = (2 * side + 1) * Q_BLOCK
    qb = q.reshape(B, nb, Q_BLOCK, KV, G, HD)

    def banded(t):
        tp = jnp.pad(t, ((0, 0), (WINDOW, WINDOW), (0, 0), (0, 0))).reshape(
            B, nb + 2 * side, Q_BLOCK, KV, HD)
        return jnp.concatenate([tp[:, j:j + nb] for j in range(2 * side + 1)], axis=2)

    kw, vw = banded(k), banded(v)
    scale = HEAD_DIM ** -0.5
    s_loc = jnp.einsum('bnqkgd,bnskd->bnkgqs', qb, kw, preferred_element_type=jnp.float32) * scale
    qpos = jnp.arange(nb)[:, None] * Q_BLOCK + jnp.arange(Q_BLOCK)[None, :]
    kpos = jnp.arange(nb)[:, None] * Q_BLOCK - WINDOW + jnp.arange(band)[None, :]
    valid = ((jnp.abs(qpos[:, :, None] - kpos[:, None, :]) <= WINDOW)
             & (kpos[:, None, :] >= 0) & (kpos[:, None, :] < L))
    s_loc = jnp.where(valid[None, :, None, None], s_loc, NEG_INF)
    s_ctx = jnp.einsum('bnqkgd,bckd->bnkgqc', qb, kc, preferred_element_type=jnp.float32) * scale
    sk = jnp.broadcast_to(sink.astype(jnp.float32).reshape(1, 1, KV, G, 1, 1),
                          (B, nb, KV, G, Q_BLOCK, 1))
    p = jax.nn.softmax(jnp.concatenate([s_loc, s_ctx, sk], axis=-1), axis=-1)
    out = (jnp.einsum('bnkgqs,bnskd->bnqkgd', p[..., :band], vw.astype(jnp.float32))
           + jnp.einsum('bnkgqc,bckd->bnqkgd', p[..., band:-1], vc.astype(jnp.float32)))
    return out.reshape(B, L, KV * G * HD)


def dense_attention(q, k_all, v_all):
    B, L, KV, G, HD = q.shape
    nb = L // Q_BLOCK
    qb = jnp.moveaxis(q.reshape(B, nb, Q_BLOCK, KV, G, HD), 1, 0)
    out = lax.map(lambda qi: full_attention(qi, k_all, v_all, None), qb)
    return jnp.moveaxis(out, 0, 1).reshape(B, L, KV * G * HD)


def mixer_layer(x, ctx, c, c_ctx, mod_w, mod_b, norm_g, w_in, w_out,
                hy_conv, hy_fw1, hy_fb1, hy_freq, hy_fw2, hy_fb2, hy_fw3, hy_bias,
                rw_conv, rw_w0, rw_w_up, rw_a0, rw_a_up, rw_k_k, rw_k_a, rw_r_k, rw_ln_g, rw_ln_b,
                wa_sink, fa_q_norm, fa_k_norm, rope_cos, rope_sin, with_ctx_out):
    dt = x.dtype
    B, L, _ = x.shape
    C = ctx.shape[1]
    shift, scale, gate = jnp.split(jax.nn.silu(c) @ mod_w + mod_b, 3, axis=-1)
    shift_c, scale_c, gate_c = jnp.split(jax.nn.silu(c_ctx) @ mod_w + mod_b, 3, axis=-1)
    h_l = rms_norm(x, norm_g) * (1.0 + scale[:, None]) + shift[:, None]
    h_c = rms_norm(ctx, norm_g) * (1.0 + scale_c) + shift_c
    hy_l, hyg_l, rw_l, rwg_l, wa_l, wag_l, fa_l, fag_l = jnp.split(h_l @ w_in, SPLIT_IDX, axis=-1)
    hy_c, hyg_c, rw_c, rwg_c, wa_c, wag_c, fa_c, fag_c = jnp.split(h_c @ w_in, SPLIT_IDX, axis=-1)

    a_l = hyena_branch(hy_l, hy_conv, hy_fw1, hy_fb1, hy_freq, hy_fw2, hy_fb2, hy_fw3, hy_bias) * jax.nn.silu(hyg_l)

    b_l, b_c = rwkv_mixer(rw_c, rw_l, rw_conv, rw_w0, rw_w_up, rw_a0, rw_a_up, rw_k_k, rw_k_a,
                          rw_r_k, rw_ln_g, rw_ln_b, with_ctx_out)
    b_l = b_l * jax.nn.silu(rwg_l)

    wa_idx = [W_WA, W_WA + WA_KV * HEAD_DIM]
    q_w, k_w, v_w = jnp.split(wa_l, wa_idx, axis=-1)
    q_cw, k_cw, v_cw = jnp.split(wa_c, wa_idx, axis=-1)
    k_cw, v_cw = heads(k_cw), heads(v_cw)
    c_l = window_attention(apply_rope(group_q(q_w, WA_KV), rope_cos, rope_sin),
                           apply_rope(heads(k_w), rope_cos, rope_sin), heads(v_w),
                           k_cw, v_cw, wa_sink) * jax.nn.silu(wag_l)

    fa_idx = [W_FA, W_FA + FA_KV * HEAD_DIM]
    q_f, k_f, v_f = jnp.split(fa_l, fa_idx, axis=-1)
    q_cf, k_cf, v_cf = jnp.split(fa_c, fa_idx, axis=-1)
    k_cf, v_cf = rms_norm(heads(k_cf), fa_k_norm), heads(v_cf)
    q_f = apply_rope(rms_norm(group_q(q_f, FA_KV), fa_q_norm), rope_cos, rope_sin)
    k_f = apply_rope(rms_norm(heads(k_f), fa_k_norm), rope_cos, rope_sin)
    k_all = jnp.concatenate([k_cf, k_f], axis=1)
    v_all = jnp.concatenate([v_cf, heads(v_f)], axis=1)
    d_l = dense_attention(q_f, k_all, v_all) * jax.nn.silu(fag_l)

    mix_l = jnp.concatenate([a_l, b_l, c_l, d_l], axis=-1).astype(dt)
    x = x + (gate[:, None] * (mix_l @ w_out)).astype(dt)
    if not with_ctx_out:
        return x, None

    a_c = hyena_branch(hy_c, hy_conv, hy_fw1, hy_fb1, hy_freq, hy_fw2, hy_fb2, hy_fw3, hy_bias) * jax.nn.silu(hyg_c)
    b_c = b_c * jax.nn.silu(rwg_c)
    c_c = full_attention(group_q(q_cw, WA_KV), k_cw, v_cw, wa_sink).reshape(B, C, W_WA) * jax.nn.silu(wag_c)
    d_c = full_attention(rms_norm(group_q(q_cf, FA_KV), fa_q_norm), k_cf, v_cf, None).reshape(B, C, W_FA) * jax.nn.silu(fag_c)
    mix_c = jnp.concatenate([a_c, b_c, c_c, d_c], axis=-1).astype(ctx.dtype)
    ctx = ctx + (gate_c * (mix_c @ w_out)).astype(ctx.dtype)
    return x, ctx


def setup_inputs(seed: int = 0) -> dict:
    key = jax.random.key(seed)
    ks = jax.random.split(key, 31)
    f32 = jnp.float32

    def nrm(k, shape, s):
        return jax.random.normal(k, shape, f32) * s

    return {
        'x': nrm(ks[0], (BATCH, SEQ, D_MODEL), 1.0),
        'c': nrm(ks[1], (BATCH, D_MODEL), 1.0),
        'ctx': nrm(ks[2], (BATCH, CTX_LEN, D_MODEL), 1.0),
        'c_ctx': nrm(ks[3], (D_MODEL,), 1.0),
        'mod_w': nrm(ks[4], (DEPTH, D_MODEL, 3 * D_MODEL), 0.5 * D_MODEL ** -0.5),
        'mod_b': nrm(ks[5], (DEPTH, 3 * D_MODEL), 0.02),
        'norm_g': 1.0 + nrm(ks[6], (DEPTH, D_MODEL), 0.02),
        'w_in': nrm(ks[7], (DEPTH, D_MODEL, D_IN), D_MODEL ** -0.5),
        'w_out': nrm(ks[8], (DEPTH, D_MIX, D_MODEL), D_MIX ** -0.5),
        'hy_conv': nrm(ks[9], (DEPTH, 3, 3 * W_HY), 3 ** -0.5),
        'hy_fw1': nrm(ks[10], (DEPTH, HY_EMB, HY_FFN), HY_EMB ** -0.5),
        'hy_fb1': nrm(ks[11], (DEPTH, HY_FFN), 0.1),
        'hy_freq': 1.0 + nrm(ks[12], (DEPTH, HY_FFN), 0.1),
        'hy_fw2': nrm(ks[13], (DEPTH, HY_FFN, HY_FFN), HY_FFN ** -0.5),
        'hy_fb2': nrm(ks[14], (DEPTH, HY_FFN), 0.1),
        'hy_fw3': nrm(ks[15], (DEPTH, HY_FFN, 4 * W_HY), HY_FFN ** -0.5),
        'hy_bias': nrm(ks[16], (DEPTH, 2, W_HY), 1.0),
        'rw_conv': nrm(ks[17], (DEPTH, 3, 3 * W_RW + RW_LORA_W + RW_LORA_A), 3 ** -0.5),
        'rw_w0': jnp.linspace(-6.0, -1.0, W_RW, dtype=f32) + nrm(ks[18], (DEPTH, 2, W_RW), 0.1),
        'rw_w_up': nrm(ks[19], (DEPTH, 2, RW_LORA_W, W_RW), 0.1),
        'rw_a0': nrm(ks[20], (DEPTH, 2, W_RW), 0.1),
        'rw_a_up': nrm(ks[21], (DEPTH, 2, RW_LORA_A, W_RW), 0.1),
        'rw_k_k': 0.85 + nrm(ks[22], (DEPTH, W_RW), 0.02),
        'rw_k_a': 1.0 + nrm(ks[23], (DEPTH, W_RW), 0.02),
        'rw_r_k': nrm(ks[24], (DEPTH, W_RW), 0.1),
        'rw_ln_g': 1.0 + nrm(ks[25], (DEPTH, W_RW), 0.02),
        'rw_ln_b': nrm(ks[26], (DEPTH, W_RW), 0.02),
        'wa_sink': nrm(ks[27], (DEPTH, WA_HEADS), 0.5),
        'fa_q_norm': 1.0 + nrm(ks[28], (DEPTH, HEAD_DIM), 0.02),
        'fa_k_norm': 1.0 + nrm(ks[29], (DEPTH, HEAD_DIM), 0.02),
        'final_g': 1.0 + nrm(ks[30], (D_MODEL,), 0.02),
    }


def reference(x, c, ctx, c_ctx, mod_w, mod_b, norm_g, w_in, w_out,
              hy_conv, hy_fw1, hy_fb1, hy_freq, hy_fw2, hy_fb2, hy_fw3, hy_bias,
              rw_conv, rw_w0, rw_w_up, rw_a0, rw_a_up, rw_k_k, rw_k_a, rw_r_k, rw_ln_g, rw_ln_b,
              wa_sink, fa_q_norm, fa_k_norm, final_g):
    rows = x.shape[1] // GRID_W
    rope_cos, rope_sin = grid_rope_tables(rows)
    for l in range(DEPTH):
        x, ctx = mixer_layer(
            x, ctx, c, c_ctx, mod_w[l], mod_b[l], norm_g[l], w_in[l], w_out[l],
            hy_conv[l], hy_fw1[l], hy_fb1[l], hy_freq[l], hy_fw2[l], hy_fb2[l], hy_fw3[l], hy_bias[l],
            rw_conv[l], rw_w0[l], rw_w_up[l], rw_a0[l], rw_a_up[l], rw_k_k[l], rw_k_a[l], rw_r_k[l],
            rw_ln_g[l], rw_ln_b[l], wa_sink[l], fa_q_norm[l], fa_k_norm[l], rope_cos, rope_sin,
            l < DEPTH - 1)
    return rms_norm(x, final_g)
```

```cpp
#include <hip/hip_runtime.h>
#include <stdint.h>
#include <stdio.h>

#ifndef EN_A
#define EN_A 1
#endif
#ifndef EN_B
#define EN_B 1
#endif
#ifndef EN_C
#define EN_C 1
#endif
#ifndef EN_D
#define EN_D 1
#endif

typedef unsigned short bf16;
typedef short bf16x8 __attribute__((ext_vector_type(8)));
typedef float f32x16 __attribute__((ext_vector_type(16)));
typedef float f32x4 __attribute__((ext_vector_type(4)));
typedef unsigned u32x4 __attribute__((ext_vector_type(4)));
typedef unsigned u32x2 __attribute__((ext_vector_type(2)));

constexpr int NB = 8, LAT = 4096, CTX = 256, DM = 1024, DEPTH = 4;
constexpr int MLAT = NB * LAT, MCTX = NB * CTX, MROWS = MLAT + MCTX, DIN = 3712;
constexpr int SKV = CTX + LAT;
constexpr int NFFT = 8192;

constexpr size_t MiB = 1u << 20;
constexpr size_t WS_MODV = 1 * MiB;
constexpr size_t WS_TW = 2 * MiB;
constexpr size_t WS_ROPE = 3 * MiB;
constexpr size_t WS_H2 = 4 * MiB;
constexpr size_t WS_HCTX = 6 * MiB;
constexpr size_t WS_WINT = 7 * MiB;
constexpr size_t WS_WOUTT = 15 * MiB;
constexpr size_t WS_CTXS = 17 * MiB;
constexpr size_t WS_KHAT = 25 * MiB;
constexpr size_t WS_VTW = 57 * MiB;
constexpr size_t WS_VTF = 66 * MiB;
constexpr size_t WS_HMIX = 75 * MiB;
constexpr size_t WS_ZHY = 143 * MiB;
constexpr size_t WS_ZRW = 194 * MiB;
constexpr size_t WS_YB = WS_ZRW + 17 * MiB;
constexpr size_t WS_ZWA = 254 * MiB;
constexpr size_t WS_ZFA = 280 * MiB;
constexpr size_t WS_GATES = 306 * MiB;
constexpr size_t WS_RW = 374 * MiB;
constexpr size_t RW_STRIDE = 17 * MiB;
constexpr size_t WS_END = WS_RW + 7 * RW_STRIDE;
static_assert(WS_END <= 512 * MiB, "workspace");
static_assert((size_t)MROWS * 256 * 2 <= RW_STRIDE, "rw stride");

struct P {
    const float* in[31];
    float* out;
    unsigned char* ws;
};
enum { I_X = 0, I_C, I_CTX, I_CCTX, I_MODW, I_MODB, I_NORMG, I_WIN, I_WOUT, I_HYCONV, I_HYFW1, I_HYFB1, I_HYFREQ, I_HYFW2, I_HYFB2, I_HYFW3,
       I_HYBIAS, I_RWCONV, I_RWW0, I_RWWUP, I_RWA0, I_RWAUP, I_RWKK, I_RWKA, I_RWRK, I_RWLNG, I_RWLNB, I_WASINK, I_FAQN, I_FAKN, I_FINALG };

__device__ __forceinline__ bf16 f2bf(float f) { unsigned u = __float_as_uint(f); return (bf16)((u + 0x7fffu + ((u >> 16) & 1u)) >> 16); }
__device__ __forceinline__ float bf2f(bf16 h) { return __uint_as_float(((unsigned)h) << 16); }
__device__ __forceinline__ unsigned pk2(float lo, float hi) { return (unsigned)f2bf(lo) | ((unsigned)f2bf(hi) << 16); }
__device__ __forceinline__ float siluf(float x) { return x / (1.0f + __expf(-x)); }
__device__ __forceinline__ float wave_sum(float v) {
#pragma unroll
    for (int o = 1; o < 64; o <<= 1) v += __shfl_xor(v, o);
    return v;
}
__device__ __forceinline__ int row_lat(int b, int t) { return b * LAT + t; }
__device__ __forceinline__ int row_ctx(int b, int t) { return MLAT + b * CTX + t; }

__global__ void __launch_bounds__(256) k_modv(P p) {
    __shared__ float sc[9 * 1024];
    const float* c = p.in[I_C]; const float* cc = p.in[I_CCTX];
    for (int i = threadIdx.x; i < 9 * 1024; i += 256) { float v = (i < 8192) ? c[i] : cc[i - 8192]; sc[i] = siluf(v); }
    __syncthreads();
    int gid = blockIdx.x * 256 + threadIdx.x;
    int l = gid / 3072, n = gid % 3072;
    const float* W = p.in[I_MODW] + (size_t)l * 1024 * 3072 + n;
    float acc[9];
#pragma unroll
    for (int i = 0; i < 9; ++i) acc[i] = 0.f;
    for (int k = 0; k < 1024; ++k) {
        float w = W[(size_t)k * 3072];
#pragma unroll
        for (int i = 0; i < 9; ++i) acc[i] += sc[i * 1024 + k] * w;
    }
    float bb = p.in[I_MODB][l * 3072 + n];
    float* o = (float*)(p.ws + WS_MODV) + (size_t)l * 9 * 3072 + n;
#pragma unroll
    for (int i = 0; i < 9; ++i) o[i * 3072] = acc[i] + bb;
}

__global__ void __launch_bounds__(256) k_tables(P p) {
    int gid = blockIdx.x * 256 + threadIdx.x;
    if (gid < 4096) {
        float s, c; sincospif((float)gid * (1.0f / 4096.0f), &s, &c);
        ((float2*)(p.ws + WS_TW))[gid] = make_float2(c, -s);
    }
    for (int i = gid; i < 4096 * 32; i += gridDim.x * 256) {
        int pos = i >> 5, sf = i & 31, s = sf >> 4, f = sf & 15;
        float inv = powf(10000.0f, -(float)f / 16.0f);
        float ang = (float)(s == 0 ? (pos >> 6) : (pos & 63)) * inv;
        ((float2*)(p.ws + WS_ROPE))[i] = make_float2(cosf(ang), sinf(ang));
    }
}

__device__ void transpose_tile(const float* W, int N, bf16* WT, int tile, float* sm  ) {
    int ntn = N / 64; int kt = tile / ntn, nt = tile % ntn; int k0 = kt * 64, n0 = nt * 64;
    for (int i = 0; i < 16; ++i) { int idx = i * 256 + threadIdx.x; int r = idx >> 6, c = idx & 63; sm[r * 65 + c] = W[(size_t)(k0 + r) * N + n0 + c]; }
    __syncthreads();
    for (int i = 0; i < 16; ++i) { int idx = i * 256 + threadIdx.x; int n = idx >> 6, k = idx & 63; WT[(size_t)(n0 + n) * 1024 + k0 + k] = f2bf(sm[k * 65 + n]); }
    __syncthreads();
}
__global__ void __launch_bounds__(256) k_wconv(P p, int l) {
    __shared__ float sm[64 * 65];
    const int T1 = 16 * (DIN / 64), T2 = 16 * 16;
    for (int t = blockIdx.x; t < T1 + T2; t += gridDim.x) {
        if (t < T1) transpose_tile(p.in[I_WIN] + (size_t)l * 1024 * DIN, DIN, (bf16*)(p.ws + WS_WINT), t, sm);
        else transpose_tile(p.in[I_WOUT] + (size_t)l * 1024 * 1024, 1024, (bf16*)(p.ws + WS_WOUTT), t - T1, sm);
    }
}

__global__ void __launch_bounds__(256) k_norm(P p, int l) {
    const int lane = threadIdx.x & 63, wave = threadIdx.x >> 6;
    const float* modv = (const float*)(p.ws + WS_MODV) + (size_t)l * 9 * 3072;
    const float* g = p.in[I_NORMG] + l * 1024;
    bf16* H = (bf16*)(p.ws + WS_HMIX);
    for (int m = blockIdx.x * 4 + wave; m < MROWS; m += gridDim.x * 4) {
        const float* src; int mi;
        if (m < MLAT) { src = (l == 0 ? p.in[I_X] : p.out) + (size_t)m * 1024; mi = m / LAT; }
        else { src = (l == 0 ? p.in[I_CTX] : (const float*)(p.ws + WS_CTXS)) + (size_t)(m - MLAT) * 1024; mi = 8; }
        const float* mv = modv + mi * 3072;
        f32x4 v[4]; float s = 0.f;
#pragma unroll
        for (int j = 0; j < 4; ++j) { v[j] = *(const f32x4*)(src + 256 * j + 4 * lane); s += v[j].x * v[j].x + v[j].y * v[j].y + v[j].z * v[j].z + v[j].w * v[j].w; }
        s = wave_sum(s);
        float rs = rsqrtf(s * (1.0f / 1024.0f) + 1e-6f);
#pragma unroll
        for (int j = 0; j < 4; ++j) {
            int c0 = 256 * j + 4 * lane;
            f32x4 gg = *(const f32x4*)(g + c0), sh = *(const f32x4*)(mv + c0), sc = *(const f32x4*)(mv + 1024 + c0);
            float o0 = v[j].x * rs * gg.x * (1.f + sc.x) + sh.x, o1 = v[j].y * rs * gg.y * (1.f + sc.y) + sh.y;
            float o2 = v[j].z * rs * gg.z * (1.f + sc.z) + sh.z, o3 = v[j].w * rs * gg.w * (1.f + sc.w) + sh.w;
            u32x2 w; w.x = pk2(o0, o1); w.y = pk2(o2, o3);
            *(u32x2*)(H + (size_t)m * 1024 + c0) = w;
        }
    }
}

__global__ void __launch_bounds__(256) k_hy_mlp(P p, int l) {
    __shared__ float z[4][36]; __shared__ float h1[4][64];
    const int j = threadIdx.x & 63, rr = threadIdx.x >> 6;
    const float* fw1 = p.in[I_HYFW1] + l * 33 * 64; const float* fb1 = p.in[I_HYFB1] + l * 64; const float* fq = p.in[I_HYFREQ] + l * 64;
    const float* fw2 = p.in[I_HYFW2] + l * 64 * 64; const float* fb2 = p.in[I_HYFB2] + l * 64;
    float* H2 = (float*)(p.ws + WS_H2);
    for (int r0 = blockIdx.x * 4; r0 < 4352; r0 += gridDim.x * 4) {
        int row = r0 + rr; int L = row < 4096 ? 4096 : 256; int t = row < 4096 ? row : row - 4096;
        if (j < 33) {
            float val;
            if (j == 0) val = (float)t / (float)(L - 1);
            else { int jj = (j - 1) & 15; float f = 1e-4f + (float)jj * ((15.0f - 1e-4f) / 15.0f); float w = (6.283185307179586f / (float)L) * (float)t; float a = f * w; val = (j <= 16) ? cosf(a) : sinf(a); }
            z[rr][j] = val;
        }
        __syncthreads();
        float a = fb1[j];
        for (int i = 0; i < 33; ++i) a += z[rr][i] * fw1[i * 64 + j];
        h1[rr][j] = sinf(fq[j] * a);
        __syncthreads();
        float b = fb2[j];
        for (int i = 0; i < 64; ++i) b += h1[rr][i] * fw2[i * 64 + j];
        H2[(size_t)row * 64 + j] = sinf(fq[j] * b);
        __syncthreads();
    }
}

#define PADI(i) ((i) + ((i) >> 5))
constexpr int XLEN = NFFT + NFFT / 32;
__device__ __forceinline__ float2 cmul(float2 a, float2 b) { return make_float2(a.x * b.x - a.y * b.y, a.x * b.y + a.y * b.x); }
__device__ __forceinline__ float2 cmulc(float2 a, float2 b) { return make_float2(a.x * b.x + a.y * b.y, a.y * b.x - a.x * b.y); }

template <int NS, int PB, bool INV>
__device__ __forceinline__ void fft_pass(float2* X, const float2* __restrict__ tw) {
    constexpr int NG = NFFT >> NS, R = 1 << NS;
    for (int g = threadIdx.x; g < NG; g += 256) {
        const int base_lo = g & ((1 << PB) - 1), base_hi = (g >> PB) << (PB + NS);
        float2 v[R];
#pragma unroll
        for (int j = 0; j < R; ++j) v[j] = X[PADI(base_hi | (j << PB) | base_lo)];
        if (!INV) {
#pragma unroll
            for (int q = NS - 1; q >= 0; --q) {
#pragma unroll
                for (int j = 0; j < R; ++j) {
                    if (j & (1 << q)) continue;
                    const int j2 = j | (1 << q);
                    const int e = (base_lo + ((j & ((1 << q) - 1)) << PB)) * (4096 >> (PB + q));
                    float2 a = v[j], b = v[j2];
                    v[j] = make_float2(a.x + b.x, a.y + b.y);
                    float2 d = make_float2(a.x - b.x, a.y - b.y);
                    v[j2] = (PB + q == 12 && false) ? d : cmul(d, tw[e]);
                }
            }
        } else {
#pragma unroll
            for (int q = 0; q < NS; ++q) {
#pragma unroll
                for (int j = 0; j < R; ++j) {
                    if (j & (1 << q)) continue;
                    const int j2 = j | (1 << q);
                    const int e = (base_lo + ((j & ((1 << q) - 1)) << PB)) * (4096 >> (PB + q));
                    float2 a = v[j], b = cmulc(v[j2], tw[e]);
                    v[j] = make_float2(a.x + b.x, a.y + b.y);
                    v[j2] = make_float2(a.x - b.x, a.y - b.y);
                }
            }
        }
#pragma unroll
        for (int j = 0; j < R; ++j) X[PADI(base_hi | (j << PB) | base_lo)] = v[j];
    }
    __syncthreads();
}
__device__ __forceinline__ void fft_fwd_hi(float2* X, const float2* tw) {
    fft_pass<4, 9, false>(X, tw); fft_pass<4, 5, false>(X, tw); fft_pass<4, 1, false>(X, tw);
}
__device__ __forceinline__ void fft_inv_hi(float2* X, const float2* tw) {
    fft_pass<4, 1, true>(X, tw); fft_pass<4, 5, true>(X, tw); fft_pass<4, 9, true>(X, tw);
}

__global__ void __launch_bounds__(256) k_hy_filt(P p, int l) {
    extern __shared__ __attribute__((aligned(16))) unsigned char smem[];
    float2* X = (float2*)smem;
    float* red = (float*)(smem + XLEN * 8);
    float* wcol = red + 8;
    const float2* tw = (const float2*)(p.ws + WS_TW);
    const float* H2 = (const float*)(p.ws + WS_H2);
    const float* fw3 = p.in[I_HYFW3] + (size_t)l * 64 * 1024;
    const int tid = threadIdx.x;
    for (int task = blockIdx.x; task < 1024; task += gridDim.x) {
        const bool isctx = task >= 512; const int oc = task & 511, o = oc >> 8, c = oc & 255;
        const int L = isctx ? 256 : 4096;
        if (tid < 128) { int d = tid >> 6, jj = tid & 63; wcol[tid] = fw3[jj * 1024 + o * 512 + d * 256 + c]; }
        __syncthreads();
        const float delta = fabsf(-3.0701134573253945f + (float)c * ((-15.350567286626973f + 3.0701134573253945f) / 255.0f));
        float hf[16], hb[16]; float asum = 0.f;
        const int nper = isctx ? 1 : 16;
#pragma unroll
        for (int i = 0; i < 16; ++i) {
            hf[i] = 0.f; hb[i] = 0.f;
            if (i < nper) {
                int t = tid + 256 * i;
                const float* hr = H2 + (size_t)((isctx ? 4096 : 0) + t) * 64;
                float a = 0.f, b = 0.f;
                for (int jj = 0; jj < 64; jj += 4) {
                    f32x4 hv = *(const f32x4*)(hr + jj);
                    a += hv.x * wcol[jj] + hv.y * wcol[jj + 1] + hv.z * wcol[jj + 2] + hv.w * wcol[jj + 3];
                    b += hv.x * wcol[64 + jj] + hv.y * wcol[64 + jj + 1] + hv.z * wcol[64 + jj + 2] + hv.w * wcol[64 + jj + 3];
                }
                float dec = expf(-((float)t / (float)(L - 1)) * delta);
                hf[i] = a * dec; hb[i] = b * dec; asum += fabsf(hf[i]) + fabsf(hb[i]);
            }
        }
        asum = wave_sum(asum);
        if ((tid & 63) == 0) red[tid >> 6] = asum;
        __syncthreads();
        const float inv = 1.0f / (red[0] + red[1] + red[2] + red[3]);
        if (isctx) {
            float* HC = (float*)(p.ws + WS_HCTX);
            HC[((o * 2 + 0) * 256 + c) * 256 + tid] = hf[0] * inv;
            HC[((o * 2 + 1) * 256 + c) * 256 + tid] = hb[0] * inv;
            __syncthreads();
            continue;
        }
        const float sc = inv * (1.0f / (float)NFFT);
#pragma unroll
        for (int i = 0; i < 16; ++i) {
            int t = tid + 256 * i;
            X[PADI(t)] = make_float2(hf[i] * sc, 0.f);
            int m2 = (t == 0) ? 4096 : (NFFT - t);
            X[PADI(m2)] = make_float2(t == 0 ? 0.f : hb[i] * sc, 0.f);
        }
        __syncthreads();
        fft_fwd_hi(X, tw);
        float2* KH = (float2*)(p.ws + WS_KHAT) + (size_t)oc * NFFT;
        for (int i = 0; i < 16; ++i) {
            int pidx = tid + 256 * i; float2 a = X[PADI(2 * pidx)], b = X[PADI(2 * pidx + 1)];
            KH[2 * pidx] = make_float2(a.x + b.x, a.y + b.y); KH[2 * pidx + 1] = make_float2(a.x - b.x, a.y - b.y);
        }
        __syncthreads();
    }
}

constexpr int GLD = 72;
template <int MODE>
__global__ void __launch_bounds__(256) k_gemm(P p, int l, int ntm, int ntn) {
    __shared__ __attribute__((aligned(16))) bf16 As[128 * GLD];
    __shared__ __attribute__((aligned(16))) bf16 Bs[128 * GLD];
    const int tid = threadIdx.x, lane = tid & 63, wave = tid >> 6, wr = wave >> 1, wc = wave & 1, r = lane & 31, hh = lane >> 5;
    const bf16* A = (const bf16*)(p.ws + WS_HMIX);
    const bf16* Bt = (const bf16*)(p.ws + (MODE == 0 ? WS_WINT : WS_WOUTT));
    for (int tile = blockIdx.x; tile < ntm * ntn; tile += gridDim.x) {
        const int tm = tile / ntn, tn = tile % ntn; const int m0 = tm * 128, n0 = tn * 128;
        f32x16 acc[2][2];
#pragma unroll
        for (int a = 0; a < 2; ++a)
#pragma unroll
            for (int b = 0; b < 2; ++b)
#pragma unroll
                for (int e = 0; e < 16; ++e) acc[a][b][e] = 0.f;
        u32x4 ra[4], rb[4];
#pragma unroll
        for (int i = 0; i < 4; ++i) { int c = tid + 256 * i, row = c >> 3, kc = c & 7;
            ra[i] = *(const u32x4*)(A + (size_t)(m0 + row) * 1024 + kc * 8); rb[i] = *(const u32x4*)(Bt + (size_t)(n0 + row) * 1024 + kc * 8); }
        for (int kt = 0; kt < 16; ++kt) {
            __syncthreads();
#pragma unroll
            for (int i = 0; i < 4; ++i) { int c = tid + 256 * i, row = c >> 3, kc = c & 7;
                *(u32x4*)(As + row * GLD + kc * 8) = ra[i]; *(u32x4*)(Bs + row * GLD + kc * 8) = rb[i]; }
            __syncthreads();
            if (kt < 15) {
#pragma unroll
                for (int i = 0; i < 4; ++i) { int c = tid + 256 * i, row = c >> 3, kc = c & 7;
                    ra[i] = *(const u32x4*)(A + (size_t)(m0 + row) * 1024 + (kt + 1) * 64 + kc * 8); rb[i] = *(const u32x4*)(Bt + (size_t)(n0 + row) * 1024 + (kt + 1) * 64 + kc * 8); }
            }
#pragma unroll
            for (int s = 0; s < 4; ++s) {
                bf16x8 af[2], bfr[2];
#pragma unroll
                for (int a = 0; a < 2; ++a) af[a] = *(const bf16x8*)(As + (wr * 64 + a * 32 + r) * GLD + s * 16 + hh * 8);
#pragma unroll
                for (int b = 0; b < 2; ++b) bfr[b] = *(const bf16x8*)(Bs + (wc * 64 + b * 32 + r) * GLD + s * 16 + hh * 8);
#pragma unroll
                for (int a = 0; a < 2; ++a)
#pragma unroll
                    for (int b = 0; b < 2; ++b) acc[a][b] = __builtin_amdgcn_mfma_f32_32x32x16_bf16(af[a], bfr[b], acc[a][b], 0, 0, 0);
            }
        }
        if (MODE == 0) {
            bf16* dst; int pitch, coff; bool vt = false;
            if (tn < 6) { dst = (bf16*)(p.ws + WS_ZHY); pitch = 768; coff = tn * 128; }
            else if (tn < 8) { dst = (bf16*)(p.ws + WS_GATES); pitch = 1024; coff = (tn - 6) * 128; }
            else if (tn < 15) { dst = (bf16*)(p.ws + WS_ZRW); pitch = 896; coff = (tn - 8) * 128; }
            else if (tn < 17) { dst = (bf16*)(p.ws + WS_GATES); pitch = 1024; coff = 256 + (tn - 15) * 128; }
            else if (tn < 20) { dst = (bf16*)(p.ws + WS_ZWA); pitch = 384; coff = (tn - 17) * 128; }
            else if (tn == 20) { dst = (bf16*)(p.ws + WS_VTW); vt = true; pitch = 0; coff = 0; }
            else if (tn < 23) { dst = (bf16*)(p.ws + WS_GATES); pitch = 1024; coff = 512 + (tn - 21) * 128; }
            else if (tn < 26) { dst = (bf16*)(p.ws + WS_ZFA); pitch = 384; coff = (tn - 23) * 128; }
            else if (tn == 26) { dst = (bf16*)(p.ws + WS_VTF); vt = true; pitch = 0; coff = 0; }
            else { dst = (bf16*)(p.ws + WS_GATES); pitch = 1024; coff = 768 + (tn - 27) * 128; }
            if (!vt) {
#pragma unroll
                for (int a = 0; a < 2; ++a)
#pragma unroll
                    for (int b = 0; b < 2; ++b)
#pragma unroll
                        for (int e = 0; e < 16; ++e) {
                            int m = m0 + wr * 64 + a * 32 + (e & 3) + 8 * (e >> 2) + 4 * hh, n = coff + wc * 64 + b * 32 + r;
                            dst[(size_t)m * pitch + n] = f2bf(acc[a][b][e]);
                        }
            } else {
#pragma unroll
                for (int a = 0; a < 2; ++a)
#pragma unroll
                    for (int b = 0; b < 2; ++b) {
                        int n = wc * 64 + b * 32 + r; int kvh = n >> 6, d = n & 63;
#pragma unroll
                        for (int g = 0; g < 4; ++g) {
                            int m = m0 + wr * 64 + a * 32 + 8 * g + 4 * hh;
                            int bb, key;
                            if (m < MLAT) { bb = m / LAT; key = CTX + (m % LAT); } else { bb = (m - MLAT) / CTX; key = (m - MLAT) % CTX; }
                            u32x2 w; w.x = pk2(acc[a][b][4 * g], acc[a][b][4 * g + 1]); w.y = pk2(acc[a][b][4 * g + 2], acc[a][b][4 * g + 3]);
                            *(u32x2*)(dst + ((size_t)(bb * 2 + kvh) * 64 + d) * SKV + key) = w;
                        }
                    }
            }
        } else {
            const float* modv = (const float*)(p.ws + WS_MODV) + (size_t)l * 9 * 3072 + 2048;
#pragma unroll
            for (int a = 0; a < 2; ++a)
#pragma unroll
                for (int b = 0; b < 2; ++b)
#pragma unroll
                    for (int e = 0; e < 16; ++e) {
                        int m = m0 + wr * 64 + a * 32 + (e & 3) + 8 * (e >> 2) + 4 * hh, n = n0 + wc * 64 + b * 32 + r;
                        if (m < MLAT) {
                            const float* xin = (l == 0 ? p.in[I_X] : p.out) + (size_t)m * 1024 + n;
                            float g = modv[(m / LAT) * 3072 + n];
                            p.out[(size_t)m * 1024 + n] = *xin + g * acc[a][b][e];
                        } else {
                            int mc = m - MLAT;
                            const float* xin = (l == 0 ? p.in[I_CTX] : (const float*)(p.ws + WS_CTXS)) + (size_t)mc * 1024 + n;
                            float g = modv[8 * 3072 + n];
                            ((float*)(p.ws + WS_CTXS))[(size_t)mc * 1024 + n] = *xin + g * acc[a][b][e];
                        }
                    }
        }
    }
}

__global__ void __launch_bounds__(256) k_rw_prep(P p, int l) {
    __shared__ float low[16][128];
    const int j = threadIdx.x;
    const bf16* Z = (const bf16*)(p.ws + WS_ZRW);
    const float* cw = p.in[I_RWCONV] + (size_t)l * 3 * 896;
    bf16* RWb = (bf16*)(p.ws + WS_RW);
    const size_t AS = RW_STRIDE / 2;
    const float kkw = p.in[I_RWKK][l * 256 + j];
    (void)kkw;
    for (int tile = blockIdx.x; tile < MROWS / 16; tile += gridDim.x) {
        const int row0 = tile * 16;
        int seq0, L;
        if (row0 < MLAT) { seq0 = (row0 / LAT) * LAT; L = LAT; } else { seq0 = MLAT + ((row0 - MLAT) / CTX) * CTX; L = CTX; }
        const int t0 = row0 - seq0;
        float wr_[3], wk_[3], wv_[3], wl_[3];
#pragma unroll
        for (int d = 0; d < 3; ++d) { wr_[d] = cw[d * 896 + j]; wk_[d] = cw[d * 896 + 256 + j]; wv_[d] = cw[d * 896 + 512 + j]; wl_[d] = (j < 128) ? cw[d * 896 + 768 + j] : 0.f; }
        float pr = 0.f, pk = 0.f, pv = 0.f, pl = 0.f, cr, ck, cv, cl = 0.f;
        if (t0 > 0) { const bf16* zr = Z + (size_t)(row0 - 1) * 896; pr = bf2f(zr[j]); pk = bf2f(zr[256 + j]); pv = bf2f(zr[512 + j]); if (j < 128) pl = bf2f(zr[768 + j]); }
        { const bf16* zr = Z + (size_t)row0 * 896; cr = bf2f(zr[j]); ck = bf2f(zr[256 + j]); cv = bf2f(zr[512 + j]); if (j < 128) cl = bf2f(zr[768 + j]); }
        for (int tt = 0; tt < 16; ++tt) {
            float nr = 0.f, nk = 0.f, nv = 0.f, nl = 0.f;
            if (t0 + tt + 1 < L) { const bf16* zr = Z + (size_t)(row0 + tt + 1) * 896; nr = bf2f(zr[j]); nk = bf2f(zr[256 + j]); nv = bf2f(zr[512 + j]); if (j < 128) nl = bf2f(zr[768 + j]); }
            float rv = pr * wr_[0] + cr * wr_[1] + nr * wr_[2];
            float kv = pk * wk_[0] + ck * wk_[1] + nk * wk_[2];
            float vv = pv * wv_[0] + cv * wv_[1] + nv * wv_[2];
            size_t o = (size_t)(row0 + tt) * 256 + j;
            RWb[0 * AS + o] = f2bf(rv); RWb[1 * AS + o] = f2bf(vv); RWb[2 * AS + o] = f2bf(kv);
            if (j < 128) { float lv = pl * wl_[0] + cl * wl_[1] + nl * wl_[2]; low[tt][j] = (j < 64) ? tanhf(lv) : lv; }
            pr = cr; pk = ck; pv = cv; pl = cl; cr = nr; ck = nk; cv = nv; cl = nl;
        }
        __syncthreads();
        float acc[16][4];
#pragma unroll
        for (int tt = 0; tt < 16; ++tt) { acc[tt][0] = 0.f; acc[tt][1] = 0.f; acc[tt][2] = 0.f; acc[tt][3] = 0.f; }
        const float* wup = p.in[I_RWWUP] + (size_t)l * 2 * 64 * 256; const float* aup = p.in[I_RWAUP] + (size_t)l * 2 * 64 * 256;
        for (int i = 0; i < 64; ++i) {
            float w0 = wup[i * 256 + j], w1 = wup[64 * 256 + i * 256 + j], a0 = aup[i * 256 + j], a1 = aup[64 * 256 + i * 256 + j];
#pragma unroll
            for (int tt = 0; tt < 16; ++tt) { float wl = low[tt][i], al = low[tt][64 + i]; acc[tt][0] += wl * w0; acc[tt][1] += wl * w1; acc[tt][2] += al * a0; acc[tt][3] += al * a1; }
        }
        const float w00 = p.in[I_RWW0][l * 512 + j], w01 = p.in[I_RWW0][l * 512 + 256 + j], a00 = p.in[I_RWA0][l * 512 + j], a01 = p.in[I_RWA0][l * 512 + 256 + j];
#pragma unroll
        for (int tt = 0; tt < 16; ++tt) {
            size_t o = (size_t)(row0 + tt) * 256 + j;
#pragma unroll
            for (int d = 0; d < 2; ++d) {
                float x = -((d == 0 ? w00 : w01) + acc[tt][d]);
                float sp = x > 20.f ? x : log1pf(__expf(x));
                float e = __expf(-sp - 0.5f);
                float a = 1.0f / (1.0f + __expf(-((d == 0 ? a00 : a01) + acc[tt][2 + d])));
                RWb[(3 + d) * AS + o] = f2bf(e); RWb[(5 + d) * AS + o] = f2bf(a);
            }
        }
        __syncthreads();
    }
}

__global__ void __launch_bounds__(256) k_attn_prep(P p, int l) {
    const int lane = threadIdx.x & 63, wave = threadIdx.x >> 6;
    const float2* rope = (const float2*)(p.ws + WS_ROPE);
    const float QS = 0.125f * 1.4426950408889634f;
    const int NITEM = MROWS * 12;
    for (int it = blockIdx.x * 4 + wave; it < NITEM; it += gridDim.x * 4) {
        const int row = it / 12, s12 = it % 12, fa = s12 >= 6, slot = s12 % 6;
        bf16* ptr = (bf16*)(p.ws + (fa ? WS_ZFA : WS_ZWA)) + (size_t)row * 384 + slot * 64 + lane;
        float x = bf2f(*ptr);
        if (fa) {
            float ss = wave_sum(x * x);
            float g = (slot < 4 ? p.in[I_FAQN] : p.in[I_FAKN])[l * 64 + lane];
            x = x * rsqrtf(ss * (1.0f / 64.0f) + 1e-6f) * g;
        }
        if (row < MLAT) {
            int pos = row % LAT;
            float other = __shfl_xor(x, 16);
            float2 cs = rope[pos * 32 + ((lane >> 5) << 4) + (lane & 15)];
            x = (lane & 16) ? (x * cs.x + other * cs.y) : (x * cs.x - other * cs.y);
        }
        if (slot < 4) x *= QS;
        *ptr = f2bf(x);
    }
}

constexpr int TC = 32;
__global__ void __launch_bounds__(256) k_rw_scan(P p, int l) {
    __shared__ __attribute__((aligned(16))) float sw[TC][64], skk[TC][64], sbb[TC][64], skd[TC][64], sr[TC][64], sv[TC][64], sy[TC][64];
    const int tid = threadIdx.x, lane = tid & 63, row = tid >> 2, part = tid & 3;
    const bf16* RWb = (const bf16*)(p.ws + WS_RW); const size_t AS = RW_STRIDE / 2;
    for (int chain = blockIdx.x; chain < 64; chain += gridDim.x) {
        const int dir = chain & 1, h = (chain >> 1) & 3, b = chain >> 3;
        bf16* Y = (bf16*)(p.ws + (dir == 0 ? WS_ZRW : WS_YB));
        const float kkw = p.in[I_RWKK][l * 256 + h * 64 + lane], kaw = p.in[I_RWKA][l * 256 + h * 64 + lane];
        float S[16];
#pragma unroll
        for (int i = 0; i < 16; ++i) S[i] = 0.f;
        const int NSTEP = CTX + LAT;
        for (int c0 = 0; c0 < NSTEP; c0 += TC) {
            __syncthreads();
#pragma unroll
            for (int i = 0; i < TC / 4; ++i) {
                int s = i * 4 + (tid >> 6); int g = c0 + s;
                int m;
                if (g < CTX) { int t = dir == 0 ? g : (CTX - 1 - g); m = row_ctx(b, t); } else { int t = dir == 0 ? (g - CTX) : (LAT - 1 - (g - CTX)); m = row_lat(b, t); }
                size_t o = (size_t)m * 256 + h * 64 + lane;
                float rv = bf2f(RWb[0 * AS + o]), vv = bf2f(RWb[1 * AS + o]), kv = bf2f(RWb[2 * AS + o]);
                float e = bf2f(RWb[(3 + dir) * AS + o]), a = bf2f(RWb[(5 + dir) * AS + o]);
                float kq = kv * kkw; float nn = sqrtf(wave_sum(kq * kq)); float kk = kq / fmaxf(nn, 1e-12f);
                sw[s][lane] = __expf(-e); skk[s][lane] = kk; sbb[s][lane] = kk * a; skd[s][lane] = kv * (1.0f + (a - 1.0f) * kaw); sr[s][lane] = rv; sv[s][lane] = vv;
            }
            __syncthreads();
            for (int s = 0; s < TC; ++s) {
                float sa = 0.f;
#pragma unroll
                for (int i = 0; i < 16; ++i) sa += S[i] * skk[s][part * 16 + i];
                sa += __shfl_xor(sa, 1); sa += __shfl_xor(sa, 2);
                sa = -sa;
                const float vv = sv[s][row];
                float y = 0.f;
#pragma unroll
                for (int i = 0; i < 16; ++i) { int k = part * 16 + i; S[i] = S[i] * sw[s][k] + sa * sbb[s][k] + vv * skd[s][k]; y += S[i] * sr[s][k]; }
                y += __shfl_xor(y, 1); y += __shfl_xor(y, 2);
                if (part == 0) sy[s][row] = y;
            }
            __syncthreads();
#pragma unroll
            for (int i = 0; i < TC / 4; ++i) {
                int s = i * 4 + (tid >> 6); int g = c0 + s; int m;
                if (g < CTX) { int t = dir == 0 ? g : (CTX - 1 - g); m = row_ctx(b, t); } else { int t = dir == 0 ? (g - CTX) : (LAT - 1 - (g - CTX)); m = row_lat(b, t); }
                Y[(size_t)m * 256 + h * 64 + lane] = f2bf(sy[s][lane]);
            }
        }
    }
}

__global__ void __launch_bounds__(256) k_rw_readout(P p, int l) {
    const int lane = threadIdx.x & 63, h = threadIdx.x >> 6;
    const bf16* RWb = (const bf16*)(p.ws + WS_RW); const size_t AS = RW_STRIDE / 2;
    const bf16* YF = (const bf16*)(p.ws + WS_ZRW); const bf16* YB = (const bf16*)(p.ws + WS_YB);
    const bf16* G = (const bf16*)(p.ws + WS_GATES); bf16* MIX = (bf16*)(p.ws + WS_HMIX);
    const int c = h * 64 + lane;
    const float kaw = p.in[I_RWKA][l * 256 + c], rk = p.in[I_RWRK][l * 256 + c], lg = p.in[I_RWLNG][l * 256 + c], lb = p.in[I_RWLNB][l * 256 + c];
    for (int m = blockIdx.x; m < MROWS; m += gridDim.x) {
        size_t o = (size_t)m * 256 + c;
#if EN_B
        float y = bf2f(YF[o]) + bf2f(YB[o]);
        float mu = wave_sum(y) * (1.0f / 64.0f); float d = y - mu; float var = wave_sum(d * d) * (1.0f / 64.0f);
        float yn = d * rsqrtf(var + 64e-5f) * lg + lb;
        float rv = bf2f(RWb[0 * AS + o]), vv = bf2f(RWb[1 * AS + o]), kv = bf2f(RWb[2 * AS + o]), af = bf2f(RWb[5 * AS + o]), ab = bf2f(RWb[6 * AS + o]);
        float ks = kv * (2.0f + (af + ab - 2.0f) * kaw);
        float bonus = wave_sum(rv * ks * rk);
        float outv = (yn + bonus * vv) * siluf(bf2f(G[(size_t)m * 1024 + 256 + c]));
#else
        float outv = 0.f;
#endif
        MIX[(size_t)m * 1024 + 256 + c] = f2bf(outv);
    }
}

__global__ void __launch_bounds__(256) k_hyena(P p, int l) {
    extern __shared__ __attribute__((aligned(16))) unsigned char smem[];
    float2* X = (float2*)smem; float2* Y1 = X + XLEN;
    const float2* tw = (const float2*)(p.ws + WS_TW);
    const bf16* Z = (const bf16*)(p.ws + WS_ZHY); const bf16* G = (const bf16*)(p.ws + WS_GATES); bf16* MIX = (bf16*)(p.ws + WS_HMIX);
    const float* cw = p.in[I_HYCONV] + (size_t)l * 3 * 768; const float* bias = p.in[I_HYBIAS] + l * 512;
    const int tid = threadIdx.x;
    for (int task = blockIdx.x; task < 1024; task += gridDim.x) {
        const int c = task >> 2, pr = task & 3; const int b0 = 2 * pr, b1 = 2 * pr + 1;
#if !EN_A
        for (int i = 0; i < 16; ++i) { int t = tid + 256 * i; MIX[(size_t)row_lat(b0, t) * 1024 + c] = 0; MIX[(size_t)row_lat(b1, t) * 1024 + c] = 0; }
        continue;
#endif
        float wv[3], w1[3], w2[3];
#pragma unroll
        for (int d = 0; d < 3; ++d) { wv[d] = cw[d * 768 + c]; w1[d] = cw[d * 768 + 256 + c]; w2[d] = cw[d * 768 + 512 + c]; }
        const float bs0 = bias[c], bs1 = bias[256 + c];
        auto cv = [&](int bb, int t, int col, const float* w) -> float {
            const bf16* zp = Z + (size_t)row_lat(bb, t) * 768 + col;
            float a = bf2f(zp[0]) * w[1];
            if (t > 0) a += bf2f(zp[-768]) * w[0];
            if (t < LAT - 1) a += bf2f(zp[768]) * w[2];
            return a;
        };
        for (int i = 0; i < 16; ++i) { int t = tid + 256 * i; X[PADI(t)] = make_float2(cv(b0, t, c, wv), cv(b1, t, c, wv)); X[PADI(4096 + t)] = make_float2(0.f, 0.f); }
        __syncthreads();
        for (int o = 0; o < 2; ++o) {
            const float2* KH = (const float2*)(p.ws + WS_KHAT) + (size_t)(o * 256 + c) * NFFT;
            fft_fwd_hi(X, tw);
            for (int i = 0; i < 16; ++i) {
                int pi = tid + 256 * i; float2 a = X[PADI(2 * pi)], bq = X[PADI(2 * pi + 1)];
                float2 u = make_float2(a.x + bq.x, a.y + bq.y), v = make_float2(a.x - bq.x, a.y - bq.y);
                u = cmul(u, KH[2 * pi]); v = cmul(v, KH[2 * pi + 1]);
                X[PADI(2 * pi)] = make_float2(u.x + v.x, u.y + v.y); X[PADI(2 * pi + 1)] = make_float2(u.x - v.x, u.y - v.y);
            }
            __syncthreads();
            fft_inv_hi(X, tw);
            if (o == 0) {
                for (int i = 0; i < 16; ++i) { int t = tid + 256 * i; float2 cvv = X[PADI(t)];
                    float y0 = cv(b0, t, 256 + c, w1) * (cvv.x + bs0 * cv(b0, t, c, wv)), y1 = cv(b1, t, 256 + c, w1) * (cvv.y + bs0 * cv(b1, t, c, wv));
                    Y1[t] = make_float2(y0, y1); }
                __syncthreads();
                for (int i = 0; i < 16; ++i) { int t = tid + 256 * i; X[PADI(t)] = Y1[t]; X[PADI(4096 + t)] = make_float2(0.f, 0.f); }
                __syncthreads();
            } else {
                for (int i = 0; i < 16; ++i) { int t = tid + 256 * i; float2 cvv = X[PADI(t)]; float2 yy = Y1[t];
                    float o0 = cv(b0, t, 512 + c, w2) * (cvv.x + bs1 * yy.x) * siluf(bf2f(G[(size_t)row_lat(b0, t) * 1024 + c]));
                    float o1 = cv(b1, t, 512 + c, w2) * (cvv.y + bs1 * yy.y) * siluf(bf2f(G[(size_t)row_lat(b1, t) * 1024 + c]));
                    MIX[(size_t)row_lat(b0, t) * 1024 + c] = f2bf(o0); MIX[(size_t)row_lat(b1, t) * 1024 + c] = f2bf(o1); }
                __syncthreads();
            }
        }
    }
}
__global__ void __launch_bounds__(256) k_hyena_ctx(P p, int l) {
    __shared__ float u[256], hf[256], hb[256];
    const bf16* Z = (const bf16*)(p.ws + WS_ZHY); const bf16* G = (const bf16*)(p.ws + WS_GATES); bf16* MIX = (bf16*)(p.ws + WS_HMIX);
    const float* cw = p.in[I_HYCONV] + (size_t)l * 3 * 768; const float* bias = p.in[I_HYBIAS] + l * 512; const float* HC = (const float*)(p.ws + WS_HCTX);
    const int t = threadIdx.x;
    for (int task = blockIdx.x; task < NB * 256; task += gridDim.x) {
        const int b = task >> 8, c = task & 255; const size_t m = row_ctx(b, t);
#if !EN_A
        MIX[m * 1024 + c] = 0; continue;
#endif
        auto cv = [&](int col) -> float { const bf16* zp = Z + m * 768 + col; float a = bf2f(zp[0]) * cw[768 + col]; if (t > 0) a += bf2f(zp[-768]) * cw[col]; if (t < CTX - 1) a += bf2f(zp[768]) * cw[2 * 768 + col]; return a; };
        float v = cv(c), x1 = cv(256 + c), x2 = cv(512 + c);
        float cur = v, res = 0.f;
        for (int o = 0; o < 2; ++o) {
            __syncthreads();
            u[t] = cur; hf[t] = HC[((o * 2 + 0) * 256 + c) * 256 + t]; hb[t] = HC[((o * 2 + 1) * 256 + c) * 256 + t];
            __syncthreads();
            float acc = 0.f;
            for (int s = 0; s <= t; ++s) acc += u[s] * hf[t - s];
            for (int s = t + 1; s < CTX; ++s) acc += u[s] * hb[s - t];
            float y = (o == 0 ? x1 : x2) * (acc + bias[o * 256 + c] * cur);
            cur = y; res = y;
        }
        MIX[m * 1024 + c] = f2bf(res * siluf(bf2f(G[m * 1024 + c])));
        __syncthreads();
    }
}

constexpr int ALD = 72;
__device__ __forceinline__ int kperm(int i) { return (i & ~12) | ((i & 8) >> 1) | ((i & 4) << 1); }
__global__ void __launch_bounds__(256) k_attn(P p, int l) {
    __shared__ __attribute__((aligned(16))) bf16 Ks[64 * ALD];
    __shared__ __attribute__((aligned(16))) bf16 Vs[64 * ALD];
    const int tid = threadIdx.x, lane = tid & 63, wave = tid >> 6, r = lane & 31, hh = lane >> 5;
    const int NT = 1024 + 1024 + 64 + 64;
    for (int task = blockIdx.x; task < NT; task += gridDim.x) {
        int kind, rem;
        if (task < 1024) { kind = 1; rem = task; } else if (task < 2048) { kind = 0; rem = task - 1024; } else if (task < 2112) { kind = 2; rem = task - 2048; } else { kind = 3; rem = task - 2112; }
        const bool win = (kind == 0 || kind == 2), qctx = kind >= 2;
        const int nqb = qctx ? 2 : 32;
        const int qb = rem % nqb, h = (rem / nqb) & 3, b = rem / (nqb * 4), kvh = h >> 1;
        const bf16* ZQ = (const bf16*)(p.ws + (win ? WS_ZWA : WS_ZFA));
        const bf16* VT = (const bf16*)(p.ws + (win ? WS_VTW : WS_VTF)) + (size_t)(b * 2 + kvh) * 64 * SKV;
        bf16* MIX = (bf16*)(p.ws + WS_HMIX); const bf16* G = (const bf16*)(p.ws + WS_GATES);
        const int mixc = (win ? 512 : 768) + h * 64;
        const int q0 = qb * 128;
        const int qpos = q0 + wave * 32 + r;
        const size_t qrow = qctx ? row_ctx(b, qpos) : row_lat(b, qpos);
        const bool enabled = win ? (EN_C != 0) : (EN_D != 0);
        if (!enabled) {
            for (int i = tid; i < 128 * 64; i += 256) { int rr = i >> 6, cc = i & 63; size_t rw = qctx ? row_ctx(b, q0 + rr) : row_lat(b, q0 + rr); MIX[rw * 1024 + mixc + cc] = 0; }
            continue;
        }
        bf16x8 qf[4];
#pragma unroll
        for (int s = 0; s < 4; ++s) qf[s] = *(const bf16x8*)(ZQ + qrow * 384 + h * 64 + s * 16 + hh * 8);
        f32x16 oacc[2];
#pragma unroll
        for (int e = 0; e < 16; ++e) { oacc[0][e] = 0.f; oacc[1][e] = 0.f; }
        float mrun = -1e30f, lrun = 0.f;
        int ntile, lt0 = 0;
        if (qctx) ntile = 4;
        else if (!win) ntile = 68;
        else { int lo = q0 - 128; if (lo < 0) lo = 0; int hi = q0 + 256; if (hi > LAT) hi = LAT; lt0 = lo / 64; ntile = 4 + (hi - lo) / 64; }
        for (int ti = 0; ti < ntile; ++ti) {
            const int kt = (ti < 4) ? ti : (win ? (4 + lt0 + (ti - 4)) : ti);
            const int key0 = kt * 64;
            const size_t krow0 = (key0 < CTX) ? (size_t)row_ctx(b, key0) : (size_t)row_lat(b, key0 - CTX);
            __syncthreads();
#pragma unroll
            for (int i = 0; i < 2; ++i) {
                int c = tid + 256 * i, rw = c >> 3, ch = c & 7;
                *(u32x4*)(Ks + rw * ALD + ch * 8) = *(const u32x4*)(ZQ + (krow0 + rw) * 384 + 256 + kvh * 64 + ch * 8);
                *(u32x4*)(Vs + rw * ALD + ch * 8) = *(const u32x4*)(VT + (size_t)rw * SKV + key0 + ch * 8);
            }
            __syncthreads();
            f32x16 sc[2];
#pragma unroll
            for (int sub = 0; sub < 2; ++sub) {
#pragma unroll
                for (int e = 0; e < 16; ++e) sc[sub][e] = 0.f;
#pragma unroll
                for (int s = 0; s < 4; ++s) {
                    bf16x8 kf = *(const bf16x8*)(Ks + (sub * 32 + kperm(r)) * ALD + s * 16 + hh * 8);
                    sc[sub] = __builtin_amdgcn_mfma_f32_32x32x16_bf16(kf, qf[s], sc[sub], 0, 0, 0);
                }
            }
            if (win && key0 >= CTX) {
#pragma unroll
                for (int sub = 0; sub < 2; ++sub)
#pragma unroll
                    for (int e = 0; e < 16; ++e) {
                        int kpos = key0 - CTX + sub * 32 + 16 * (e >> 3) + 8 * hh + (e & 7);
                        int dlt = qpos - kpos; if (dlt < 0) dlt = -dlt;
                        if (dlt > 128) sc[sub][e] = -1e30f;
                    }
            }
            float mx = sc[0][0];
#pragma unroll
            for (int e = 1; e < 16; ++e) mx = fmaxf(mx, sc[0][e]);
#pragma unroll
            for (int e = 0; e < 16; ++e) mx = fmaxf(mx, sc[1][e]);
            mx = fmaxf(mx, __shfl_xor(mx, 32));
            const float mnew = fmaxf(mrun, mx);
            const float alpha = exp2f(mrun - mnew);
            mrun = mnew;
            float ps = 0.f;
            bf16x8 pf[2][2];
#pragma unroll
            for (int sub = 0; sub < 2; ++sub)
#pragma unroll
                for (int s2 = 0; s2 < 2; ++s2) {
                    float pe[8];
#pragma unroll
                    for (int jj = 0; jj < 8; ++jj) { pe[jj] = exp2f(sc[sub][8 * s2 + jj] - mnew); ps += pe[jj]; }
                    u32x4 w; w.x = pk2(pe[0], pe[1]); w.y = pk2(pe[2], pe[3]); w.z = pk2(pe[4], pe[5]); w.w = pk2(pe[6], pe[7]);
                    pf[sub][s2] = __builtin_bit_cast(bf16x8, w);
                }
            lrun = lrun * alpha + ps;
#pragma unroll
            for (int e = 0; e < 16; ++e) { oacc[0][e] *= alpha; oacc[1][e] *= alpha; }
#pragma unroll
            for (int dt = 0; dt < 2; ++dt)
#pragma unroll
                for (int sub = 0; sub < 2; ++sub)
#pragma unroll
                    for (int s2 = 0; s2 < 2; ++s2) {
                        bf16x8 vf = *(const bf16x8*)(Vs + (dt * 32 + r) * ALD + sub * 32 + s2 * 16 + hh * 8);
                        oacc[dt] = __builtin_amdgcn_mfma_f32_32x32x16_bf16(vf, pf[sub][s2], oacc[dt], 0, 0, 0);
                    }
        }
        lrun += __shfl_xor(lrun, 32);
        if (win) lrun += exp2f(p.in[I_WASINK][l * 4 + h] * 1.4426950408889634f - mrun);
        const float inv = 1.0f / lrun;
#pragma unroll
        for (int dt = 0; dt < 2; ++dt)
#pragma unroll
            for (int g = 0; g < 4; ++g) {
                int d0 = dt * 32 + 8 * g + 4 * hh;
                u32x2 gv = *(const u32x2*)(G + qrow * 1024 + mixc + d0);
                float g0 = bf2f((bf16)(gv.x & 0xffff)), g1 = bf2f((bf16)(gv.x >> 16)), g2 = bf2f((bf16)(gv.y & 0xffff)), g3 = bf2f((bf16)(gv.y >> 16));
                u32x2 w; w.x = pk2(oacc[dt][4 * g] * inv * siluf(g0), oacc[dt][4 * g + 1] * inv * siluf(g1));
                w.y = pk2(oacc[dt][4 * g + 2] * inv * siluf(g2), oacc[dt][4 * g + 3] * inv * siluf(g3));
                *(u32x2*)(MIX + qrow * 1024 + mixc + d0) = w;
            }
    }
}

__global__ void __launch_bounds__(256) k_final(P p) {
    const int lane = threadIdx.x & 63, wave = threadIdx.x >> 6;
    const float* g = p.in[I_FINALG];
    for (int m = blockIdx.x * 4 + wave; m < MLAT; m += gridDim.x * 4) {
        float* src = p.out + (size_t)m * 1024;
        f32x4 v[4]; float s = 0.f;
#pragma unroll
        for (int j = 0; j < 4; ++j) { v[j] = *(const f32x4*)(src + 256 * j + 4 * lane); s += v[j].x * v[j].x + v[j].y * v[j].y + v[j].z * v[j].z + v[j].w * v[j].w; }
        s = wave_sum(s);
        float rs = rsqrtf(s * (1.0f / 1024.0f) + 1e-6f);
#pragma unroll
        for (int j = 0; j < 4; ++j) { f32x4 gg = *(const f32x4*)(g + 256 * j + 4 * lane); f32x4 o; o.x = v[j].x * rs * gg.x; o.y = v[j].y * rs * gg.y; o.z = v[j].z * rs * gg.z; o.w = v[j].w * rs * gg.w; *(f32x4*)(src + 256 * j + 4 * lane) = o; }
    }
}

extern "C" void kernel_launch(void* const* d_in, const int* in_sizes, int n_in, void* d_out, int out_size, void* d_ws, size_t ws_size, hipStream_t stream) {
    if (n_in != 31 || ws_size < WS_END) { fprintf(stderr, "kernel_launch: unexpected inputs (n_in %d, ws %zu)\n", n_in, ws_size); return; }
    P p{};
    for (int i = 0; i < 31; ++i) p.in[i] = (const float*)d_in[i];
    p.out = (float*)d_out; p.ws = (unsigned char*)d_ws;
    const int HY_LDS = XLEN * 8 + 4096 * 8, FILT_LDS = XLEN * 8 + 1024;
    static bool attr_done = false;
    if (!attr_done) {
        hipFuncSetAttribute((const void*)k_hyena, hipFuncAttributeMaxDynamicSharedMemorySize, HY_LDS);
        hipFuncSetAttribute((const void*)k_hy_filt, hipFuncAttributeMaxDynamicSharedMemorySize, FILT_LDS);
        attr_done = true;
    }
    k_modv<<<48, 256, 0, stream>>>(p);
    k_tables<<<64, 256, 0, stream>>>(p);
    for (int l = 0; l < DEPTH; ++l) {
        k_wconv<<<1024, 256, 0, stream>>>(p, l);
        k_norm<<<2048, 256, 0, stream>>>(p, l);
        k_hy_mlp<<<1088, 256, 0, stream>>>(p, l);
        k_hy_filt<<<1024, 256, FILT_LDS, stream>>>(p, l);
        k_gemm<0><<<272 * 29, 256, 0, stream>>>(p, l, 272, 29);
        k_rw_prep<<<MROWS / 16, 256, 0, stream>>>(p, l);
        k_attn_prep<<<4096, 256, 0, stream>>>(p, l);
        k_rw_scan<<<64, 256, 0, stream>>>(p, l);
        k_hyena<<<1024, 256, HY_LDS, stream>>>(p, l);
        if (l < DEPTH - 1) k_hyena_ctx<<<2048, 256, 0, stream>>>(p, l);
        k_attn<<<2176, 256, 0, stream>>>(p, l);
        k_rw_readout<<<4096, 256, 0, stream>>>(p, l);
        if (l < DEPTH - 1) k_gemm<1><<<272 * 8, 256, 0, stream>>>(p, l, 272, 8);
        else k_gemm<1><<<256 * 8, 256, 0, stream>>>(p, l, 256, 8);
    }
    k_final<<<2048, 256, 0, stream>>>(p);
}
```

```cpp
#include <hip/hip_runtime.h>
#include <hip/hip_cooperative_groups.h>
#include <stdint.h>
#include <stdio.h>
namespace cg = cooperative_groups;

#ifndef EN_A
#define EN_A 1
#endif
#ifndef EN_B
#define EN_B 1
#endif
#ifndef EN_C
#define EN_C 1
#endif
#ifndef EN_D
#define EN_D 1
#endif

typedef unsigned short bf16;
typedef short bf16x8 __attribute__((ext_vector_type(8)));
typedef float f32x16 __attribute__((ext_vector_type(16)));
typedef float f32x4 __attribute__((ext_vector_type(4)));
typedef unsigned u32x4 __attribute__((ext_vector_type(4)));
typedef unsigned u32x2 __attribute__((ext_vector_type(2)));

constexpr int NT = 512;
constexpr int NB = 8, LAT = 4096, CTX = 256, DM = 1024, DEPTH = 4;
constexpr int MLAT = NB * LAT, MCTX = NB * CTX, MROWS = MLAT + MCTX, DIN = 3712;
constexpr int SKV = CTX + LAT;
constexpr int NFFT = 8192;

constexpr size_t MiB = 1u << 20;
constexpr size_t WS_CTL = 0;
constexpr size_t WS_MODV = 1 * MiB;
constexpr size_t WS_TW = 2 * MiB;
constexpr size_t WS_ROPE = 3 * MiB;
constexpr size_t WS_H2 = 4 * MiB;
constexpr size_t WS_HCTX = 6 * MiB;
constexpr size_t WS_WINT = 7 * MiB;
constexpr size_t WS_WOUTT = 15 * MiB;
constexpr size_t WS_CTXS = 17 * MiB;
constexpr size_t WS_KHAT = 25 * MiB;
constexpr size_t WS_VTW = 57 * MiB;
constexpr size_t WS_VTF = 66 * MiB;
constexpr size_t WS_HMIX = 75 * MiB;
constexpr size_t WS_ZHY = 143 * MiB;
constexpr size_t WS_ZRW = 194 * MiB;
constexpr size_t WS_YB = WS_ZRW + 17 * MiB;
constexpr size_t WS_ZWA = 254 * MiB;
constexpr size_t WS_ZFA = 280 * MiB;
constexpr size_t WS_GATES = 306 * MiB;
constexpr size_t WS_RW = 374 * MiB;
constexpr size_t RW_STRIDE = 17 * MiB;
constexpr size_t WS_END = WS_RW + 7 * RW_STRIDE;
static_assert(WS_END <= 512 * MiB, "workspace");
static_assert((size_t)MROWS * 256 * 2 <= RW_STRIDE, "rw stride");

constexpr int LDS_BYTES = 112 * 1024;

struct P {
    const float* in[31];
    float* out;
    unsigned char* ws;
};
enum { I_X = 0, I_C, I_CTX, I_CCTX, I_MODW, I_MODB, I_NORMG, I_WIN, I_WOUT, I_HYCONV, I_HYFW1, I_HYFB1, I_HYFREQ, I_HYFW2, I_HYFB2, I_HYFW3,
       I_HYBIAS, I_RWCONV, I_RWW0, I_RWWUP, I_RWA0, I_RWAUP, I_RWKK, I_RWKA, I_RWRK, I_RWLNG, I_RWLNB, I_WASINK, I_FAQN, I_FAKN, I_FINALG };

__device__ __forceinline__ bf16 f2bf(float f) { unsigned u = __float_as_uint(f); return (bf16)((u + 0x7fffu + ((u >> 16) & 1u)) >> 16); }
__device__ __forceinline__ float bf2f(bf16 h) { return __uint_as_float(((unsigned)h) << 16); }
__device__ __forceinline__ unsigned pk2(float lo, float hi) { return (unsigned)f2bf(lo) | ((unsigned)f2bf(hi) << 16); }
__device__ __forceinline__ float siluf(float x) { return x / (1.0f + __expf(-x)); }
__device__ __forceinline__ int tidx() { int t = threadIdx.x; asm volatile("" : "+v"(t)); return t; }
__device__ __forceinline__ float wave_sum(float v) {
#pragma unroll
    for (int o = 1; o < 64; o <<= 1) v += __shfl_xor(v, o);
    return v;
}
__device__ __forceinline__ float red_rev(float x) { float r = x * 0.15915494309189535f; return r - rintf(r); }
__device__ __forceinline__ float fsin(float x) { return __builtin_amdgcn_sinf(red_rev(x)); }
__device__ __forceinline__ float fcos(float x) { return __builtin_amdgcn_cosf(red_rev(x)); }
__device__ __forceinline__ int row_lat(int b, int t) { return b * LAT + t; }
__device__ __forceinline__ int row_ctx(int b, int t) { return MLAT + b * CTX + t; }

__device__ void ph_modv(const P& p, unsigned char* smem, int bid, int nblk) {
    if (bid * NT >= 4 * 3072) return;
    float* sc = (float*)smem;
    const float* c = p.in[I_C]; const float* cc = p.in[I_CCTX];
    for (int i = tidx(); i < 9 * 1024; i += NT) { float v = (i < 8192) ? c[i] : cc[i - 8192]; sc[i] = siluf(v); }
    __syncthreads();
    for (int gid = bid * NT + tidx(); gid < 4 * 3072; gid += nblk * NT) {
        int l = gid / 3072, n = gid % 3072;
        const float* W = p.in[I_MODW] + (size_t)l * 1024 * 3072 + n;
        float acc[9];
#pragma unroll
        for (int i = 0; i < 9; ++i) acc[i] = 0.f;
        for (int k = 0; k < 1024; ++k) {
            float w = W[(size_t)k * 3072];
#pragma unroll
            for (int i = 0; i < 9; ++i) acc[i] += sc[i * 1024 + k] * w;
        }
        float bb = p.in[I_MODB][l * 3072 + n];
        float* o = (float*)(p.ws + WS_MODV) + (size_t)l * 9 * 3072 + n;
#pragma unroll
        for (int i = 0; i < 9; ++i) o[i * 3072] = acc[i] + bb;
    }
    __syncthreads();
}

__device__ void ph_tables(const P& p, int bid, int nblk) {
    for (int gid = bid * NT + tidx(); gid < 4096; gid += nblk * NT) {
        float rev = (float)gid * (1.0f / 8192.0f);
        ((float2*)(p.ws + WS_TW))[gid] = make_float2(__builtin_amdgcn_cosf(rev), -__builtin_amdgcn_sinf(rev));
    }
    for (int i = bid * NT + tidx(); i < 4096 * 32; i += nblk * NT) {
        int pos = i >> 5, sf = i & 31, s = sf >> 4, f = sf & 15;
        float inv = exp2f(-(float)f * (13.287712379549449f / 16.0f));
        float ang = (float)(s == 0 ? (pos >> 6) : (pos & 63)) * inv;
        ((float2*)(p.ws + WS_ROPE))[i] = make_float2(fcos(ang), fsin(ang));
    }
}

__device__ void transpose_tile(const float* W, int N, bf16* WT, int tile, float* sm  ) {
    int ntn = N / 64; int kt = tile / ntn, nt = tile % ntn; int k0 = kt * 64, n0 = nt * 64;
    for (int i = 0; i < 4096 / NT; ++i) { int idx = i * NT + tidx(); int r = idx >> 6, c = idx & 63; sm[r * 65 + c] = W[(size_t)(k0 + r) * N + n0 + c]; }
    __syncthreads();
    for (int i = 0; i < 4096 / NT; ++i) { int idx = i * NT + tidx(); int n = idx >> 6, k = idx & 63; WT[(size_t)(n0 + n) * 1024 + k0 + k] = f2bf(sm[k * 65 + n]); }
    __syncthreads();
}
__device__ void ph_wconv(const P& p, int l, unsigned char* smem, int bid, int nblk) {
    float* sm = (float*)smem;
    const int T1 = 16 * (DIN / 64), T2 = 16 * 16;
    for (int t = bid; t < T1 + T2; t += nblk) {
        if (t < T1) transpose_tile(p.in[I_WIN] + (size_t)l * 1024 * DIN, DIN, (bf16*)(p.ws + WS_WINT), t, sm);
        else transpose_tile(p.in[I_WOUT] + (size_t)l * 1024 * 1024, 1024, (bf16*)(p.ws + WS_WOUTT), t - T1, sm);
    }
}

__device__ void ph_norm(const P& p, int l, int bid, int nblk) {
    const int lane = tidx() & 63, wave = tidx() >> 6;
    const float* modv = (const float*)(p.ws + WS_MODV) + (size_t)l * 9 * 3072;
    const float* g = p.in[I_NORMG] + l * 1024;
    bf16* H = (bf16*)(p.ws + WS_HMIX);
    for (int m = bid * 8 + wave; m < MROWS; m += nblk * 8) {
        const float* src; int mi;
        if (m < MLAT) { src = (l == 0 ? p.in[I_X] : p.out) + (size_t)m * 1024; mi = m / LAT; }
        else { src = (l == 0 ? p.in[I_CTX] : (const float*)(p.ws + WS_CTXS)) + (size_t)(m - MLAT) * 1024; mi = 8; }
        const float* mv = modv + mi * 3072;
        f32x4 v[4]; float s = 0.f;
#pragma unroll
        for (int j = 0; j < 4; ++j) { v[j] = *(const f32x4*)(src + 256 * j + 4 * lane); s += v[j].x * v[j].x + v[j].y * v[j].y + v[j].z * v[j].z + v[j].w * v[j].w; }
        s = wave_sum(s);
        float rs = rsqrtf(s * (1.0f / 1024.0f) + 1e-6f);
#pragma unroll
        for (int j = 0; j < 4; ++j) {
            int c0 = 256 * j + 4 * lane;
            f32x4 gg = *(const f32x4*)(g + c0), sh = *(const f32x4*)(mv + c0), sc = *(const f32x4*)(mv + 1024 + c0);
            float o0 = v[j].x * rs * gg.x * (1.f + sc.x) + sh.x, o1 = v[j].y * rs * gg.y * (1.f + sc.y) + sh.y;
            float o2 = v[j].z * rs * gg.z * (1.f + sc.z) + sh.z, o3 = v[j].w * rs * gg.w * (1.f + sc.w) + sh.w;
            u32x2 w; w.x = pk2(o0, o1); w.y = pk2(o2, o3);
            *(u32x2*)(H + (size_t)m * 1024 + c0) = w;
        }
    }
}

__device__ void ph_hy_mlp(const P& p, int l, unsigned char* smem, int bid, int nblk) {
    float (*z)[36] = (float (*)[36])smem; float (*h1)[64] = (float (*)[64])(smem + 8 * 36 * 4);
    const int j = tidx() & 63, rr = tidx() >> 6;
    const float* fw1 = p.in[I_HYFW1] + l * 33 * 64; const float* fb1 = p.in[I_HYFB1] + l * 64; const float* fq = p.in[I_HYFREQ] + l * 64;
    const float* fw2 = p.in[I_HYFW2] + l * 64 * 64; const float* fb2 = p.in[I_HYFB2] + l * 64;
    float* H2 = (float*)(p.ws + WS_H2);
    for (int r0 = bid * 8; r0 < 4352; r0 += nblk * 8) {
        int row = r0 + rr; int L = row < 4096 ? 4096 : 256; int t = row < 4096 ? row : row - 4096;
        if (j < 33) {
            float val;
            if (j == 0) val = (float)t / (float)(L - 1);
            else { int jj = (j - 1) & 15; float f = 1e-4f + (float)jj * ((15.0f - 1e-4f) / 15.0f); float w = (6.283185307179586f / (float)L) * (float)t; float a = f * w; val = (j <= 16) ? fcos(a) : fsin(a); }
            z[rr][j] = val;
        }
        __syncthreads();
        float a = fb1[j];
#pragma unroll 3
        for (int i = 0; i < 33; ++i) a += z[rr][i] * fw1[i * 64 + j];
        h1[rr][j] = fsin(fq[j] * a);
        __syncthreads();
        float b = fb2[j];
#pragma unroll 8
        for (int i = 0; i < 64; ++i) b += h1[rr][i] * fw2[i * 64 + j];
        H2[(size_t)row * 64 + j] = fsin(fq[j] * b);
        __syncthreads();
    }
}

#define PADI(i) ((i) + ((i) >> 5))
constexpr int XLEN = NFFT + NFFT / 32;
__device__ __forceinline__ float2 cmul(float2 a, float2 b) { return make_float2(a.x * b.x - a.y * b.y, a.x * b.y + a.y * b.x); }
__device__ __forceinline__ float2 cmulc(float2 a, float2 b) { return make_float2(a.x * b.x + a.y * b.y, a.y * b.x - a.x * b.y); }

template <int NS, int PB, bool INV>
__device__ __forceinline__ void fft_pass(float2* X, const float2* __restrict__ tw) {
    constexpr int NG = NFFT >> NS, R = 1 << NS;
    for (int g = tidx(); g < NG; g += NT) {
        const int base_lo = g & ((1 << PB) - 1), base_hi = (g >> PB) << (PB + NS);
        float2 v[R];
#pragma unroll
        for (int j = 0; j < R; ++j) v[j] = X[PADI(base_hi | (j << PB) | base_lo)];
        if (!INV) {
#pragma unroll
            for (int q = NS - 1; q >= 0; --q) {
#pragma unroll
                for (int j = 0; j < R; ++j) {
                    if (j & (1 << q)) continue;
                    const int j2 = j | (1 << q);
                    const int e = (base_lo + ((j & ((1 << q) - 1)) << PB)) * (4096 >> (PB + q));
                    float2 a = v[j], b = v[j2];
                    v[j] = make_float2(a.x + b.x, a.y + b.y);
                    v[j2] = cmul(make_float2(a.x - b.x, a.y - b.y), tw[e]);
                }
            }
        } else {
#pragma unroll
            for (int q = 0; q < NS; ++q) {
#pragma unroll
                for (int j = 0; j < R; ++j) {
                    if (j & (1 << q)) continue;
                    const int j2 = j | (1 << q);
                    const int e = (base_lo + ((j & ((1 << q) - 1)) << PB)) * (4096 >> (PB + q));
                    float2 a = v[j], b = cmulc(v[j2], tw[e]);
                    v[j] = make_float2(a.x + b.x, a.y + b.y);
                    v[j2] = make_float2(a.x - b.x, a.y - b.y);
                }
            }
        }
#pragma unroll
        for (int j = 0; j < R; ++j) X[PADI(base_hi | (j << PB) | base_lo)] = v[j];
    }
    __syncthreads();
}
__device__ __forceinline__ void fft_fwd_hi(float2* X, const float2* tw) { fft_pass<4, 9, false>(X, tw); fft_pass<4, 5, false>(X, tw); fft_pass<4, 1, false>(X, tw); }
__device__ __forceinline__ void fft_inv_hi(float2* X, const float2* tw) { fft_pass<4, 1, true>(X, tw); fft_pass<4, 5, true>(X, tw); fft_pass<4, 9, true>(X, tw); }

__device__ void ph_hy_filt(const P& p, int l, unsigned char* smem, int bid, int nblk) {
    float2* X = (float2*)smem;
    float* red = (float*)(smem + XLEN * 8);
    float* wcol = red + 8;
    const float2* tw = (const float2*)(p.ws + WS_TW);
    const float* H2 = (const float*)(p.ws + WS_H2);
    const float* fw3 = p.in[I_HYFW3] + (size_t)l * 64 * 1024;
    const int tid = tidx();
    for (int task = bid; task < 1024; task += nblk) {
        const bool isctx = task >= 512; const int oc = task & 511, o = oc >> 8, c = oc & 255;
        const int L = isctx ? 256 : 4096;
        if (tid < 128) { int d = tid >> 6, jj = tid & 63; wcol[tid] = fw3[jj * 1024 + o * 512 + d * 256 + c]; }
        __syncthreads();
        const float delta = fabsf(-3.0701134573253945f + (float)c * ((-15.350567286626973f + 3.0701134573253945f) / 255.0f));
        float asum = 0.f; float hf0 = 0.f, hb0 = 0.f;
        const int nper = isctx ? 1 : 8;
        for (int i = 0; i < nper; ++i) {
            int t = tid + NT * i;
            if (t < L) {
                const float* hr = H2 + (size_t)((isctx ? 4096 : 0) + t) * 64;
                float a = 0.f, b = 0.f;
#pragma unroll 4
                for (int jj = 0; jj < 64; jj += 4) {
                    f32x4 hv = *(const f32x4*)(hr + jj);
                    a += hv.x * wcol[jj] + hv.y * wcol[jj + 1] + hv.z * wcol[jj + 2] + hv.w * wcol[jj + 3];
                    b += hv.x * wcol[64 + jj] + hv.y * wcol[64 + jj + 1] + hv.z * wcol[64 + jj + 2] + hv.w * wcol[64 + jj + 3];
                }
                float dec = __expf(-((float)t / (float)(L - 1)) * delta);
                a *= dec; b *= dec; asum += fabsf(a) + fabsf(b);
                if (isctx) { hf0 = a; hb0 = b; }
                else {
                    X[PADI(t)] = make_float2(a, 0.f);
                    int m2 = (t == 0) ? 4096 : (NFFT - t);
                    X[PADI(m2)] = make_float2(t == 0 ? 0.f : b, 0.f);
                }
            }
        }
        asum = wave_sum(asum);
        if ((tid & 63) == 0) red[tid >> 6] = asum;
        __syncthreads();
        float tot = 0.f;
#pragma unroll
        for (int i = 0; i < 8; ++i) tot += red[i];
        const float inv = 1.0f / tot;
        if (isctx) {
            float* HC = (float*)(p.ws + WS_HCTX);
            if (tid < 256) { HC[((o * 2 + 0) * 256 + c) * 256 + tid] = hf0 * inv; HC[((o * 2 + 1) * 256 + c) * 256 + tid] = hb0 * inv; }
            __syncthreads();
            continue;
        }
        const float sc = inv * (1.0f / (float)NFFT);
        __syncthreads();
        fft_fwd_hi(X, tw);
        float2* KH = (float2*)(p.ws + WS_KHAT) + (size_t)oc * NFFT;
        for (int i = 0; i < 8; ++i) {
            int pidx = tid + NT * i; float2 a = X[PADI(2 * pidx)], b = X[PADI(2 * pidx + 1)];
            KH[2 * pidx] = make_float2((a.x + b.x) * sc, (a.y + b.y) * sc); KH[2 * pidx + 1] = make_float2((a.x - b.x) * sc, (a.y - b.y) * sc);
        }
        __syncthreads();
    }
}

constexpr int GLD = 72;
template <int MODE>
__device__ void ph_gemm(const P& p, int l, int ntm, int ntn, unsigned char* smem, int bid, int nblk) {
    const int half = tidx() >> 8, tid = tidx() & 255;
    bf16* As = (bf16*)smem + half * (2 * 128 * GLD); bf16* Bs = As + 128 * GLD;
    const int lane = tid & 63, wave = tid >> 6, wr = wave >> 1, wc = wave & 1, r = lane & 31, hh = lane >> 5;
    const bf16* A = (const bf16*)(p.ws + WS_HMIX);
    const bf16* Bt = (const bf16*)(p.ws + (MODE == 0 ? WS_WINT : WS_WOUTT));
    const int ntiles = ntm * ntn;
    for (int tile2 = bid; tile2 < ntiles / 2; tile2 += nblk) {
        const int tile = tile2 * 2 + half;
        const int tm = tile / ntn, tn = tile % ntn; const int m0 = tm * 128, n0 = tn * 128;
        f32x16 acc[2][2];
#pragma unroll
        for (int a = 0; a < 2; ++a)
#pragma unroll
            for (int b = 0; b < 2; ++b)
#pragma unroll
                for (int e = 0; e < 16; ++e) acc[a][b][e] = 0.f;
        u32x4 ra[4], rb[4];
#pragma unroll
        for (int i = 0; i < 4; ++i) { int c = tid + 256 * i, row = c >> 3, kc = c & 7;
            ra[i] = *(const u32x4*)(A + (size_t)(m0 + row) * 1024 + kc * 8); rb[i] = *(const u32x4*)(Bt + (size_t)(n0 + row) * 1024 + kc * 8); }
        for (int kt = 0; kt < 16; ++kt) {
            __syncthreads();
#pragma unroll
            for (int i = 0; i < 4; ++i) { int c = tid + 256 * i, row = c >> 3, kc = c & 7;
                *(u32x4*)(As + row * GLD + kc * 8) = ra[i]; *(u32x4*)(Bs + row * GLD + kc * 8) = rb[i]; }
            __syncthreads();
            if (kt < 15) {
#pragma unroll
                for (int i = 0; i < 4; ++i) { int c = tid + 256 * i, row = c >> 3, kc = c & 7;
                    ra[i] = *(const u32x4*)(A + (size_t)(m0 + row) * 1024 + (kt + 1) * 64 + kc * 8); rb[i] = *(const u32x4*)(Bt + (size_t)(n0 + row) * 1024 + (kt + 1) * 64 + kc * 8); }
            }
#pragma unroll
            for (int s = 0; s < 4; ++s) {
                bf16x8 af[2], bfr[2];
#pragma unroll
                for (int a = 0; a < 2; ++a) af[a] = *(const bf16x8*)(As + (wr * 64 + a * 32 + r) * GLD + s * 16 + hh * 8);
#pragma unroll
                for (int b = 0; b < 2; ++b) bfr[b] = *(const bf16x8*)(Bs + (wc * 64 + b * 32 + r) * GLD + s * 16 + hh * 8);
#pragma unroll
                for (int a = 0; a < 2; ++a)
#pragma unroll
                    for (int b = 0; b < 2; ++b) acc[a][b] = __builtin_amdgcn_mfma_f32_32x32x16_bf16(af[a], bfr[b], acc[a][b], 0, 0, 0);
            }
        }
        if (MODE == 0) {
            bf16* dst; int pitch, coff; bool vt = false;
            if (tn < 6) { dst = (bf16*)(p.ws + WS_ZHY); pitch = 768; coff = tn * 128; }
            else if (tn < 8) { dst = (bf16*)(p.ws + WS_GATES); pitch = 1024; coff = (tn - 6) * 128; }
            else if (tn < 15) { dst = (bf16*)(p.ws + WS_ZRW); pitch = 896; coff = (tn - 8) * 128; }
            else if (tn < 17) { dst = (bf16*)(p.ws + WS_GATES); pitch = 1024; coff = 256 + (tn - 15) * 128; }
            else if (tn < 20) { dst = (bf16*)(p.ws + WS_ZWA); pitch = 384; coff = (tn - 17) * 128; }
            else if (tn == 20) { dst = (bf16*)(p.ws + WS_VTW); vt = true; pitch = 0; coff = 0; }
            else if (tn < 23) { dst = (bf16*)(p.ws + WS_GATES); pitch = 1024; coff = 512 + (tn - 21) * 128; }
            else if (tn < 26) { dst = (bf16*)(p.ws + WS_ZFA); pitch = 384; coff = (tn - 23) * 128; }
            else if (tn == 26) { dst = (bf16*)(p.ws + WS_VTF); vt = true; pitch = 0; coff = 0; }
            else { dst = (bf16*)(p.ws + WS_GATES); pitch = 1024; coff = 768 + (tn - 27) * 128; }
            if (!vt) {
#pragma unroll
                for (int a = 0; a < 2; ++a)
#pragma unroll
                    for (int b = 0; b < 2; ++b)
#pragma unroll
                        for (int e = 0; e < 16; ++e) {
                            int m = m0 + wr * 64 + a * 32 + (e & 3) + 8 * (e >> 2) + 4 * hh, n = coff + wc * 64 + b * 32 + r;
                            dst[(size_t)m * pitch + n] = f2bf(acc[a][b][e]);
                        }
            } else {
#pragma unroll
                for (int a = 0; a < 2; ++a)
#pragma unroll
                    for (int b = 0; b < 2; ++b) {
                        int n = wc * 64 + b * 32 + r; int kvh = n >> 6, d = n & 63;
#pragma unroll
                        for (int g = 0; g < 4; ++g) {
                            int m = m0 + wr * 64 + a * 32 + 8 * g + 4 * hh;
                            int bb, key;
                            if (m < MLAT) { bb = m / LAT; key = CTX + (m % LAT); } else { bb = (m - MLAT) / CTX; key = (m - MLAT) % CTX; }
                            u32x2 w; w.x = pk2(acc[a][b][4 * g], acc[a][b][4 * g + 1]); w.y = pk2(acc[a][b][4 * g + 2], acc[a][b][4 * g + 3]);
                            *(u32x2*)(dst + ((size_t)(bb * 2 + kvh) * 64 + d) * SKV + key) = w;
                        }
                    }
            }
        } else {
            const float* modv = (const float*)(p.ws + WS_MODV) + (size_t)l * 9 * 3072 + 2048;
#pragma unroll
            for (int a = 0; a < 2; ++a)
#pragma unroll
                for (int b = 0; b < 2; ++b)
#pragma unroll
                    for (int e = 0; e < 16; ++e) {
                        int m = m0 + wr * 64 + a * 32 + (e & 3) + 8 * (e >> 2) + 4 * hh, n = n0 + wc * 64 + b * 32 + r;
                        if (m < MLAT) {
                            const float* xin = (l == 0 ? p.in[I_X] : p.out) + (size_t)m * 1024 + n;
                            float g = modv[(m / LAT) * 3072 + n];
                            p.out[(size_t)m * 1024 + n] = *xin + g * acc[a][b][e];
                        } else {
                            int mc = m - MLAT;
                            const float* xin = (l == 0 ? p.in[I_CTX] : (const float*)(p.ws + WS_CTXS)) + (size_t)mc * 1024 + n;
                            float g = modv[8 * 3072 + n];
                            ((float*)(p.ws + WS_CTXS))[(size_t)mc * 1024 + n] = *xin + g * acc[a][b][e];
                        }
                    }
        }
    }
    __syncthreads();
}

__device__ void ph_rw_prep(const P& p, int l, unsigned char* smem, int bid, int nblk) {
    const int half = tidx() >> 8, j = tidx() & 255;
    float (*low)[128] = (float (*)[128])(smem + half * 16 * 128 * 4);
    const bf16* Z = (const bf16*)(p.ws + WS_ZRW);
    const float* cw = p.in[I_RWCONV] + (size_t)l * 3 * 896;
    bf16* RWb = (bf16*)(p.ws + WS_RW);
    const size_t AS = RW_STRIDE / 2;
    for (int tile2 = bid; tile2 < MROWS / 32; tile2 += nblk) {
        const int tile = tile2 * 2 + half;
        const int row0 = tile * 16;
        int seq0, L;
        if (row0 < MLAT) { seq0 = (row0 / LAT) * LAT; L = LAT; } else { seq0 = MLAT + ((row0 - MLAT) / CTX) * CTX; L = CTX; }
        const int t0 = row0 - seq0;
        float wr_[3], wk_[3], wv_[3], wl_[3];
#pragma unroll
        for (int d = 0; d < 3; ++d) { wr_[d] = cw[d * 896 + j]; wk_[d] = cw[d * 896 + 256 + j]; wv_[d] = cw[d * 896 + 512 + j]; wl_[d] = (j < 128) ? cw[d * 896 + 768 + j] : 0.f; }
        float pr = 0.f, pk = 0.f, pv = 0.f, pl = 0.f, cr, ck, cv, cl = 0.f;
        if (t0 > 0) { const bf16* zr = Z + (size_t)(row0 - 1) * 896; pr = bf2f(zr[j]); pk = bf2f(zr[256 + j]); pv = bf2f(zr[512 + j]); if (j < 128) pl = bf2f(zr[768 + j]); }
        { const bf16* zr = Z + (size_t)row0 * 896; cr = bf2f(zr[j]); ck = bf2f(zr[256 + j]); cv = bf2f(zr[512 + j]); if (j < 128) cl = bf2f(zr[768 + j]); }
        for (int tt = 0; tt < 16; ++tt) {
            float nr = 0.f, nk = 0.f, nv = 0.f, nl = 0.f;
            if (t0 + tt + 1 < L) { const bf16* zr = Z + (size_t)(row0 + tt + 1) * 896; nr = bf2f(zr[j]); nk = bf2f(zr[256 + j]); nv = bf2f(zr[512 + j]); if (j < 128) nl = bf2f(zr[768 + j]); }
            float rv = pr * wr_[0] + cr * wr_[1] + nr * wr_[2];
            float kv = pk * wk_[0] + ck * wk_[1] + nk * wk_[2];
            float vv = pv * wv_[0] + cv * wv_[1] + nv * wv_[2];
            size_t o = (size_t)(row0 + tt) * 256 + j;
            RWb[0 * AS + o] = f2bf(rv); RWb[1 * AS + o] = f2bf(vv); RWb[2 * AS + o] = f2bf(kv);
            if (j < 128) { float lv = pl * wl_[0] + cl * wl_[1] + nl * wl_[2]; low[tt][j] = (j < 64) ? tanhf(lv) : lv; }
            pr = cr; pk = ck; pv = cv; pl = cl; cr = nr; ck = nk; cv = nv; cl = nl;
        }
        __syncthreads();
        float acc[16][4];
#pragma unroll
        for (int tt = 0; tt < 16; ++tt) { acc[tt][0] = 0.f; acc[tt][1] = 0.f; acc[tt][2] = 0.f; acc[tt][3] = 0.f; }
        const float* wup = p.in[I_RWWUP] + (size_t)l * 2 * 64 * 256; const float* aup = p.in[I_RWAUP] + (size_t)l * 2 * 64 * 256;
        for (int i = 0; i < 64; ++i) {
            float w0 = wup[i * 256 + j], w1 = wup[64 * 256 + i * 256 + j], a0 = aup[i * 256 + j], a1 = aup[64 * 256 + i * 256 + j];
#pragma unroll
            for (int tt = 0; tt < 16; ++tt) { float wl = low[tt][i], al = low[tt][64 + i]; acc[tt][0] += wl * w0; acc[tt][1] += wl * w1; acc[tt][2] += al * a0; acc[tt][3] += al * a1; }
        }
        const float w00 = p.in[I_RWW0][l * 512 + j], w01 = p.in[I_RWW0][l * 512 + 256 + j], a00 = p.in[I_RWA0][l * 512 + j], a01 = p.in[I_RWA0][l * 512 + 256 + j];
#pragma unroll
        for (int tt = 0; tt < 16; ++tt) {
            size_t o = (size_t)(row0 + tt) * 256 + j;
#pragma unroll
            for (int d = 0; d < 2; ++d) {
                float x = -((d == 0 ? w00 : w01) + acc[tt][d]);
                float sp = x > 20.f ? x : log1pf(__expf(x));
                float e = __expf(-sp - 0.5f);
                float a = 1.0f / (1.0f + __expf(-((d == 0 ? a00 : a01) + acc[tt][2 + d])));
                RWb[(3 + d) * AS + o] = f2bf(e); RWb[(5 + d) * AS + o] = f2bf(a);
            }
        }
        __syncthreads();
    }
}

__device__ void ph_attn_prep(const P& p, int l, int bid, int nblk) {
    const int lane = tidx() & 63, wave = tidx() >> 6;
    const float2* rope = (const float2*)(p.ws + WS_ROPE);
    const float QS = 0.125f * 1.4426950408889634f;
    const int NITEM = MROWS * 12;
    for (int it = bid * 8 + wave; it < NITEM; it += nblk * 8) {
        const int row = it / 12, s12 = it % 12, fa = s12 >= 6, slot = s12 % 6;
        bf16* ptr = (bf16*)(p.ws + (fa ? WS_ZFA : WS_ZWA)) + (size_t)row * 384 + slot * 64 + lane;
        float x = bf2f(*ptr);
        if (fa) {
            float ss = wave_sum(x * x);
            float g = (slot < 4 ? p.in[I_FAQN] : p.in[I_FAKN])[l * 64 + lane];
            x = x * rsqrtf(ss * (1.0f / 64.0f) + 1e-6f) * g;
        }
        if (row < MLAT) {
            int pos = row % LAT;
            float other = __shfl_xor(x, 16);
            float2 cs = rope[pos * 32 + ((lane >> 5) << 4) + (lane & 15)];
            x = (lane & 16) ? (x * cs.x + other * cs.y) : (x * cs.x - other * cs.y);
        }
        if (slot < 4) x *= QS;
        *ptr = f2bf(x);
    }
}

constexpr int TC = 32;
__device__ void rw_scan_chain(const P& p, int l, int chain, unsigned char* smem) {
    float (*sw)[64] = (float (*)[64])smem; float (*skk)[64] = sw + TC; float (*sbb)[64] = skk + TC; float (*skd)[64] = sbb + TC;
    float (*sr)[64] = skd + TC; float (*sv)[64] = sr + TC; float (*sy)[64] = sv + TC;
    const int tid = tidx(), lane = tid & 63, wave = tid >> 6, row = tid >> 3, part = tid & 7;
    const bf16* RWb = (const bf16*)(p.ws + WS_RW); const size_t AS = RW_STRIDE / 2;
    const int dir = chain & 1, h = (chain >> 1) & 3, b = chain >> 3;
    bf16* Y = (bf16*)(p.ws + (dir == 0 ? WS_ZRW : WS_YB));
    const float kkw = p.in[I_RWKK][l * 256 + h * 64 + lane], kaw = p.in[I_RWKA][l * 256 + h * 64 + lane];
    float S[8];
#pragma unroll
    for (int i = 0; i < 8; ++i) S[i] = 0.f;
    const int NSTEP = CTX + LAT;
    for (int c0 = 0; c0 < NSTEP; c0 += TC) {
        __syncthreads();
#pragma unroll
        for (int i = 0; i < TC / 8; ++i) {
            int s = i * 8 + wave; int g = c0 + s;
            int m;
            if (g < CTX) { int t = dir == 0 ? g : (CTX - 1 - g); m = row_ctx(b, t); } else { int t = dir == 0 ? (g - CTX) : (LAT - 1 - (g - CTX)); m = row_lat(b, t); }
            size_t o = (size_t)m * 256 + h * 64 + lane;
            float rv = bf2f(RWb[0 * AS + o]), vv = bf2f(RWb[1 * AS + o]), kv = bf2f(RWb[2 * AS + o]);
            float e = bf2f(RWb[(3 + dir) * AS + o]), a = bf2f(RWb[(5 + dir) * AS + o]);
            float kq = kv * kkw; float nn = sqrtf(wave_sum(kq * kq)); float kk = kq / fmaxf(nn, 1e-12f);
            sw[s][lane] = __expf(-e); skk[s][lane] = kk; sbb[s][lane] = kk * a; skd[s][lane] = kv * (1.0f + (a - 1.0f) * kaw); sr[s][lane] = rv; sv[s][lane] = vv;
        }
        __syncthreads();
        for (int s = 0; s < TC; ++s) {
            float sa = 0.f;
#pragma unroll
            for (int i = 0; i < 8; ++i) sa += S[i] * skk[s][part * 8 + i];
            sa += __shfl_xor(sa, 1); sa += __shfl_xor(sa, 2); sa += __shfl_xor(sa, 4);
            sa = -sa;
            const float vv = sv[s][row];
            float y = 0.f;
#pragma unroll
            for (int i = 0; i < 8; ++i) { int k = part * 8 + i; S[i] = S[i] * sw[s][k] + sa * sbb[s][k] + vv * skd[s][k]; y += S[i] * sr[s][k]; }
            y += __shfl_xor(y, 1); y += __shfl_xor(y, 2); y += __shfl_xor(y, 4);
            if (part == 0) sy[s][row] = y;
        }
        __syncthreads();
#pragma unroll
        for (int i = 0; i < TC / 8; ++i) {
            int s = i * 8 + wave; int g = c0 + s; int m;
            if (g < CTX) { int t = dir == 0 ? g : (CTX - 1 - g); m = row_ctx(b, t); } else { int t = dir == 0 ? (g - CTX) : (LAT - 1 - (g - CTX)); m = row_lat(b, t); }
            Y[(size_t)m * 256 + h * 64 + lane] = f2bf(sy[s][lane]);
        }
    }
    __syncthreads();
}

__device__ void ph_rw_readout(const P& p, int l, int bid, int nblk) {
    const int lane = tidx() & 63, wave = tidx() >> 6, h = wave & 3, sub = wave >> 2;
    const bf16* RWb = (const bf16*)(p.ws + WS_RW); const size_t AS = RW_STRIDE / 2;
    const bf16* YF = (const bf16*)(p.ws + WS_ZRW); const bf16* YB = (const bf16*)(p.ws + WS_YB);
    const bf16* G = (const bf16*)(p.ws + WS_GATES); bf16* MIX = (bf16*)(p.ws + WS_HMIX);
    const int c = h * 64 + lane;
    const float kaw = p.in[I_RWKA][l * 256 + c], rk = p.in[I_RWRK][l * 256 + c], lg = p.in[I_RWLNG][l * 256 + c], lb = p.in[I_RWLNB][l * 256 + c];
    for (int m = bid * 2 + sub; m < MROWS; m += nblk * 2) {
        size_t o = (size_t)m * 256 + c;
#if EN_B
        float y = bf2f(YF[o]) + bf2f(YB[o]);
        float mu = wave_sum(y) * (1.0f / 64.0f); float d = y - mu; float var = wave_sum(d * d) * (1.0f / 64.0f);
        float yn = d * rsqrtf(var + 64e-5f) * lg + lb;
        float rv = bf2f(RWb[0 * AS + o]), vv = bf2f(RWb[1 * AS + o]), kv = bf2f(RWb[2 * AS + o]), af = bf2f(RWb[5 * AS + o]), ab = bf2f(RWb[6 * AS + o]);
        float ks = kv * (2.0f + (af + ab - 2.0f) * kaw);
        float bonus = wave_sum(rv * ks * rk);
        float outv = (yn + bonus * vv) * siluf(bf2f(G[(size_t)m * 1024 + 256 + c]));
#else
        float outv = 0.f;
#endif
        MIX[(size_t)m * 1024 + 256 + c] = f2bf(outv);
    }
}

__device__ void hyena_task(const P& p, int l, int task, unsigned char* smem) {
    float2* X = (float2*)smem; float2* Y1 = X + XLEN;
    const float2* tw = (const float2*)(p.ws + WS_TW);
    const bf16* Z = (const bf16*)(p.ws + WS_ZHY); const bf16* G = (const bf16*)(p.ws + WS_GATES); bf16* MIX = (bf16*)(p.ws + WS_HMIX);
    const float* cw = p.in[I_HYCONV] + (size_t)l * 3 * 768; const float* bias = p.in[I_HYBIAS] + l * 512;
    const int tid = tidx();
    const int c = task >> 2, pr = task & 3; const int b0 = 2 * pr, b1 = 2 * pr + 1;
#if !EN_A
    for (int i = 0; i < 8; ++i) { int t = tid + NT * i; MIX[(size_t)row_lat(b0, t) * 1024 + c] = 0; MIX[(size_t)row_lat(b1, t) * 1024 + c] = 0; }
    return;
#endif
    float wv[3], w1[3], w2[3];
#pragma unroll
    for (int d = 0; d < 3; ++d) { wv[d] = cw[d * 768 + c]; w1[d] = cw[d * 768 + 256 + c]; w2[d] = cw[d * 768 + 512 + c]; }
    const float bs0 = bias[c], bs1 = bias[256 + c];
    auto cv = [&](int bb, int t, int col, const float* w) -> float {
        const bf16* zp = Z + (size_t)row_lat(bb, t) * 768 + col;
        float a = bf2f(zp[0]) * w[1];
        if (t > 0) a += bf2f(zp[-768]) * w[0];
        if (t < LAT - 1) a += bf2f(zp[768]) * w[2];
        return a;
    };
#pragma unroll 2
    for (int i = 0; i < 8; ++i) { int t = tid + NT * i; X[PADI(t)] = make_float2(cv(b0, t, c, wv), cv(b1, t, c, wv)); X[PADI(4096 + t)] = make_float2(0.f, 0.f); }
    __syncthreads();
    for (int o = 0; o < 2; ++o) {
        const float2* KH = (const float2*)(p.ws + WS_KHAT) + (size_t)(o * 256 + c) * NFFT;
        fft_fwd_hi(X, tw);
#pragma unroll 2
        for (int i = 0; i < 8; ++i) {
            int pi = tid + NT * i; float2 a = X[PADI(2 * pi)], bq = X[PADI(2 * pi + 1)];
            float2 u = make_float2(a.x + bq.x, a.y + bq.y), v = make_float2(a.x - bq.x, a.y - bq.y);
            u = cmul(u, KH[2 * pi]); v = cmul(v, KH[2 * pi + 1]);
            X[PADI(2 * pi)] = make_float2(u.x + v.x, u.y + v.y); X[PADI(2 * pi + 1)] = make_float2(u.x - v.x, u.y - v.y);
        }
        __syncthreads();
        fft_inv_hi(X, tw);
        if (o == 0) {
#pragma unroll 1
            for (int i = 0; i < 8; ++i) { int t = tid + NT * i; float2 cvv = X[PADI(t)];
                float y0 = cv(b0, t, 256 + c, w1) * (cvv.x + bs0 * cv(b0, t, c, wv)), y1 = cv(b1, t, 256 + c, w1) * (cvv.y + bs0 * cv(b1, t, c, wv));
                Y1[t] = make_float2(y0, y1); }
            __syncthreads();
#pragma unroll 2
            for (int i = 0; i < 8; ++i) { int t = tid + NT * i; X[PADI(t)] = Y1[t]; X[PADI(4096 + t)] = make_float2(0.f, 0.f); }
            __syncthreads();
        } else {
#pragma unroll 1
            for (int i = 0; i < 8; ++i) { int t = tid + NT * i; float2 cvv = X[PADI(t)]; float2 yy = Y1[t];
                float o0 = cv(b0, t, 512 + c, w2) * (cvv.x + bs1 * yy.x) * siluf(bf2f(G[(size_t)row_lat(b0, t) * 1024 + c]));
                float o1 = cv(b1, t, 512 + c, w2) * (cvv.y + bs1 * yy.y) * siluf(bf2f(G[(size_t)row_lat(b1, t) * 1024 + c]));
                MIX[(size_t)row_lat(b0, t) * 1024 + c] = f2bf(o0); MIX[(size_t)row_lat(b1, t) * 1024 + c] = f2bf(o1); }
            __syncthreads();
        }
    }
}
__device__ void hyena_ctx_task(const P& p, int l, int task2, unsigned char* smem) {
    const int half = tidx() >> 8, t = tidx() & 255;
    float* u = (float*)smem + half * 768; float* hf = u + 256; float* hb = hf + 256;
    const bf16* Z = (const bf16*)(p.ws + WS_ZHY); const bf16* G = (const bf16*)(p.ws + WS_GATES); bf16* MIX = (bf16*)(p.ws + WS_HMIX);
    const float* cw = p.in[I_HYCONV] + (size_t)l * 3 * 768; const float* bias = p.in[I_HYBIAS] + l * 512; const float* HC = (const float*)(p.ws + WS_HCTX);
    const int task = task2 * 2 + half;
    const int b = task >> 8, c = task & 255; const size_t m = row_ctx(b, t);
#if !EN_A
    MIX[m * 1024 + c] = 0; return;
#endif
    auto cv = [&](int col) -> float { const bf16* zp = Z + m * 768 + col; float a = bf2f(zp[0]) * cw[768 + col]; if (t > 0) a += bf2f(zp[-768]) * cw[col]; if (t < CTX - 1) a += bf2f(zp[768]) * cw[2 * 768 + col]; return a; };
    float v = cv(c), x1 = cv(256 + c), x2 = cv(512 + c);
    float cur = v, res = 0.f;
    for (int o = 0; o < 2; ++o) {
        __syncthreads();
        u[t] = cur; hf[t] = HC[((o * 2 + 0) * 256 + c) * 256 + t]; hb[t] = HC[((o * 2 + 1) * 256 + c) * 256 + t];
        __syncthreads();
        float acc = 0.f;
        for (int s = 0; s <= t; ++s) acc += u[s] * hf[t - s];
        for (int s = t + 1; s < CTX; ++s) acc += u[s] * hb[s - t];
        float y = (o == 0 ? x1 : x2) * (acc + bias[o * 256 + c] * cur);
        cur = y; res = y;
    }
    MIX[m * 1024 + c] = f2bf(res * siluf(bf2f(G[m * 1024 + c])));
    __syncthreads();
}

constexpr int ALD = 72;
__device__ __forceinline__ int kperm(int i) { return (i & ~12) | ((i & 8) >> 1) | ((i & 4) << 1); }
__device__ void attn_task(const P& p, int l, int task, unsigned char* smem) {
    bf16* Ks = (bf16*)smem; bf16* Vs = Ks + 64 * ALD;
    const int tid = tidx(), lane = tid & 63, wave = tid >> 6, r = lane & 31, hh = lane >> 5;
    int kind, rem;
    if (task < 512) { kind = 1; rem = task; } else if (task < 1024) { kind = 0; rem = task - 512; } else if (task < 1056) { kind = 2; rem = task - 1024; } else { kind = 3; rem = task - 1056; }
    const bool win = (kind == 0 || kind == 2), qctx = kind >= 2;
    const int nqb = qctx ? 2 : 32;
    const int qb = rem % nqb, kvh = (rem / nqb) & 1, b = rem / (nqb * 2), h = kvh * 2 + (wave >> 2);
    const bf16* ZQ = (const bf16*)(p.ws + (win ? WS_ZWA : WS_ZFA));
    const bf16* VT = (const bf16*)(p.ws + (win ? WS_VTW : WS_VTF)) + (size_t)(b * 2 + kvh) * 64 * SKV;
    bf16* MIX = (bf16*)(p.ws + WS_HMIX); const bf16* G = (const bf16*)(p.ws + WS_GATES);
    const int mixc = (win ? 512 : 768) + h * 64;
    const int q0 = qb * 128;
    const int qpos = q0 + (wave & 3) * 32 + r;
    const size_t qrow = qctx ? row_ctx(b, qpos) : row_lat(b, qpos);
    const bool enabled = win ? (EN_C != 0) : (EN_D != 0);
    if (!enabled) {
        for (int i = tid; i < 128 * 128; i += NT) { int rr = i >> 7, cc = i & 127; size_t rw = qctx ? row_ctx(b, q0 + rr) : row_lat(b, q0 + rr); MIX[rw * 1024 + (win ? 512 : 768) + kvh * 128 + cc] = 0; }
        return;
    }
    bf16x8 qf[4];
#pragma unroll
    for (int s = 0; s < 4; ++s) qf[s] = *(const bf16x8*)(ZQ + qrow * 384 + h * 64 + s * 16 + hh * 8);
    f32x16 oacc[2];
#pragma unroll
    for (int e = 0; e < 16; ++e) { oacc[0][e] = 0.f; oacc[1][e] = 0.f; }
    float mrun = -1e30f, lrun = 0.f;
    int ntile, lt0 = 0;
    if (qctx) ntile = 4;
    else if (!win) ntile = 68;
    else { int lo = q0 - 128; if (lo < 0) lo = 0; int hi = q0 + 256; if (hi > LAT) hi = LAT; lt0 = lo / 64; ntile = 4 + (hi - lo) / 64; }
    for (int ti = 0; ti < ntile; ++ti) {
        const int kt = (ti < 4) ? ti : (win ? (4 + lt0 + (ti - 4)) : ti);
        const int key0 = kt * 64;
        const size_t krow0 = (key0 < CTX) ? (size_t)row_ctx(b, key0) : (size_t)row_lat(b, key0 - CTX);
        __syncthreads();
        { int rw = tid >> 3, ch = tid & 7;
          *(u32x4*)(Ks + rw * ALD + ch * 8) = *(const u32x4*)(ZQ + (krow0 + rw) * 384 + 256 + kvh * 64 + ch * 8);
          *(u32x4*)(Vs + rw * ALD + ch * 8) = *(const u32x4*)(VT + (size_t)rw * SKV + key0 + ch * 8); }
        __syncthreads();
        f32x16 sc[2];
#pragma unroll
        for (int sub = 0; sub < 2; ++sub) {
#pragma unroll
            for (int e = 0; e < 16; ++e) sc[sub][e] = 0.f;
#pragma unroll
            for (int s = 0; s < 4; ++s) {
                bf16x8 kf = *(const bf16x8*)(Ks + (sub * 32 + kperm(r)) * ALD + s * 16 + hh * 8);
                sc[sub] = __builtin_amdgcn_mfma_f32_32x32x16_bf16(kf, qf[s], sc[sub], 0, 0, 0);
            }
        }
        if (win && key0 >= CTX) {
#pragma unroll
            for (int sub = 0; sub < 2; ++sub)
#pragma unroll
                for (int e = 0; e < 16; ++e) {
                    int kpos = key0 - CTX + sub * 32 + 16 * (e >> 3) + 8 * hh + (e & 7);
                    int dlt = qpos - kpos; if (dlt < 0) dlt = -dlt;
                    if (dlt > 128) sc[sub][e] = -1e30f;
                }
        }
        float mx = sc[0][0];
#pragma unroll
        for (int e = 1; e < 16; ++e) mx = fmaxf(mx, sc[0][e]);
#pragma unroll
        for (int e = 0; e < 16; ++e) mx = fmaxf(mx, sc[1][e]);
        mx = fmaxf(mx, __shfl_xor(mx, 32));
        const float mnew = fmaxf(mrun, mx);
        const float alpha = exp2f(mrun - mnew);
        mrun = mnew;
        float ps = 0.f;
        bf16x8 pf[2][2];
#pragma unroll
        for (int sub = 0; sub < 2; ++sub)
#pragma unroll
            for (int s2 = 0; s2 < 2; ++s2) {
                float pe[8];
#pragma unroll
                for (int jj = 0; jj < 8; ++jj) { pe[jj] = exp2f(sc[sub][8 * s2 + jj] - mnew); ps += pe[jj]; }
                u32x4 w; w.x = pk2(pe[0], pe[1]); w.y = pk2(pe[2], pe[3]); w.z = pk2(pe[4], pe[5]); w.w = pk2(pe[6], pe[7]);
                pf[sub][s2] = __builtin_bit_cast(bf16x8, w);
            }
        lrun = lrun * alpha + ps;
#pragma unroll
        for (int e = 0; e < 16; ++e) { oacc[0][e] *= alpha; oacc[1][e] *= alpha; }
#pragma unroll
        for (int dt = 0; dt < 2; ++dt)
#pragma unroll
            for (int sub = 0; sub < 2; ++sub)
#pragma unroll
                for (int s2 = 0; s2 < 2; ++s2) {
                    bf16x8 vf = *(const bf16x8*)(Vs + (dt * 32 + r) * ALD + sub * 32 + s2 * 16 + hh * 8);
                    oacc[dt] = __builtin_amdgcn_mfma_f32_32x32x16_bf16(vf, pf[sub][s2], oacc[dt], 0, 0, 0);
                }
    }
    lrun += __shfl_xor(lrun, 32);
    if (win) lrun += exp2f(p.in[I_WASINK][l * 4 + h] * 1.4426950408889634f - mrun);
    const float inv = 1.0f / lrun;
#pragma unroll
    for (int dt = 0; dt < 2; ++dt)
#pragma unroll
        for (int g = 0; g < 4; ++g) {
            int d0 = dt * 32 + 8 * g + 4 * hh;
            u32x2 gv = *(const u32x2*)(G + qrow * 1024 + mixc + d0);
            float g0 = bf2f((bf16)(gv.x & 0xffff)), g1 = bf2f((bf16)(gv.x >> 16)), g2 = bf2f((bf16)(gv.y & 0xffff)), g3 = bf2f((bf16)(gv.y >> 16));
            u32x2 w; w.x = pk2(oacc[dt][4 * g] * inv * siluf(g0), oacc[dt][4 * g + 1] * inv * siluf(g1));
            w.y = pk2(oacc[dt][4 * g + 2] * inv * siluf(g2), oacc[dt][4 * g + 3] * inv * siluf(g3));
            *(u32x2*)(MIX + qrow * 1024 + mixc + d0) = w;
        }
    __syncthreads();
}

constexpr int MIX_NATT = 1088, MIX_NHY = 1024, MIX_NHYC = 1024;
__device__ void ph_mixer(const P& p, int l, unsigned char* smem, int bid, int nblk) {
    volatile int* s_task = (volatile int*)(smem + LDS_BYTES - 16);
    if (bid < 64) {
#if EN_B
        rw_scan_chain(p, l, bid, smem);
#endif
    }
    unsigned* ctr = (unsigned*)(p.ws + WS_CTL) + 64 * (1 + l);
    const int ntask = MIX_NATT + MIX_NHY + (l < DEPTH - 1 ? MIX_NHYC : 0);
    for (;;) {
        __syncthreads();
        if (tidx() == 0) *s_task = (int)atomicAdd(ctr, 1u);
        __syncthreads();
        const int t = *s_task;
        if (t >= ntask) break;
        P q = p; asm volatile("" : "+s"(q.ws), "+s"(q.out));
        if (t < MIX_NATT) attn_task(q, l, t, smem);
        else if (t < MIX_NATT + MIX_NHY) hyena_task(q, l, t - MIX_NATT, smem);
        else hyena_ctx_task(q, l, t - MIX_NATT - MIX_NHY, smem);
    }
}

__device__ void ph_final(const P& p, int bid, int nblk) {
    const int lane = tidx() & 63, wave = tidx() >> 6;
    const float* g = p.in[I_FINALG];
    for (int m = bid * 8 + wave; m < MLAT; m += nblk * 8) {
        float* src = p.out + (size_t)m * 1024;
        f32x4 v[4]; float s = 0.f;
#pragma unroll
        for (int j = 0; j < 4; ++j) { v[j] = *(const f32x4*)(src + 256 * j + 4 * lane); s += v[j].x * v[j].x + v[j].y * v[j].y + v[j].z * v[j].z + v[j].w * v[j].w; }
        s = wave_sum(s);
        float rs = rsqrtf(s * (1.0f / 1024.0f) + 1e-6f);
#pragma unroll
        for (int j = 0; j < 4; ++j) { f32x4 gg = *(const f32x4*)(g + 256 * j + 4 * lane); f32x4 o; o.x = v[j].x * rs * gg.x; o.y = v[j].y * rs * gg.y; o.z = v[j].z * rs * gg.z; o.w = v[j].w * rs * gg.w; *(f32x4*)(src + 256 * j + 4 * lane) = o; }
    }
}

#define FENCE(q) do { asm volatile("" : "+s"(q.ws), "+s"(q.out)); } while (0)
__global__ void __launch_bounds__(NT) mega(P p) {
    extern __shared__ __attribute__((aligned(16))) unsigned char smem[];
    cg::grid_group grid = cg::this_grid();
    const int bid = blockIdx.x, nblk = gridDim.x;
    P q = p;
    FENCE(q); ph_modv(q, smem, bid, nblk);
    FENCE(q); ph_tables(q, bid, nblk);
    FENCE(q); ph_wconv(q, 0, smem, bid, nblk);
    FENCE(q); ph_hy_mlp(q, 0, smem, bid, nblk);
    grid.sync();
    for (int l = 0; l < DEPTH; ++l) {
        if (l > 0) { FENCE(q); ph_wconv(q, l, smem, bid, nblk); FENCE(q); ph_hy_mlp(q, l, smem, bid, nblk); }
        FENCE(q); ph_norm(q, l, bid, nblk);
        grid.sync();
        FENCE(q); ph_hy_filt(q, l, smem, bid, nblk);
        FENCE(q); ph_gemm<0>(q, l, 272, 29, smem, bid, nblk);
        grid.sync();
        FENCE(q); ph_rw_prep(q, l, smem, bid, nblk);
        FENCE(q); ph_attn_prep(q, l, bid, nblk);
        grid.sync();
        FENCE(q); ph_mixer(q, l, smem, bid, nblk);
        grid.sync();
        FENCE(q); ph_rw_readout(q, l, bid, nblk);
        grid.sync();
        FENCE(q); ph_gemm<1>(q, l, l < DEPTH - 1 ? 272 : 256, 8, smem, bid, nblk);
        grid.sync();
    }
    FENCE(q); ph_final(q, bid, nblk);
}

extern "C" void kernel_launch(void* const* d_in, const int* in_sizes, int n_in, void* d_out, int out_size, void* d_ws, size_t ws_size, hipStream_t stream) {
    if (n_in != 31 || ws_size < WS_END) { fprintf(stderr, "kernel_launch: unexpected inputs (n_in %d, ws %zu)\n", n_in, ws_size); return; }
    static int grid_blocks = 0;
    if (!grid_blocks) {
        int dev = 0, cus = 0, per_cu = 0;
        (void)hipGetDevice(&dev);
        (void)hipDeviceGetAttribute(&cus, hipDeviceAttributeMultiprocessorCount, dev);
        (void)hipFuncSetAttribute((const void*)mega, hipFuncAttributeMaxDynamicSharedMemorySize, LDS_BYTES);
        (void)hipOccupancyMaxActiveBlocksPerMultiprocessor(&per_cu, (const void*)mega, NT, LDS_BYTES);
        if (per_cu < 1) { fprintf(stderr, "kernel_launch: occupancy query says %d blocks per CU\n", per_cu); per_cu = 1; }
        grid_blocks = cus;
    }
    P p{};
    for (int i = 0; i < 31; ++i) p.in[i] = (const float*)d_in[i];
    p.out = (float*)d_out; p.ws = (unsigned char*)d_ws;
    (void)hipMemsetAsync((unsigned char*)d_ws + WS_CTL, 0, 4096, stream);
    void* args[] = {&p};
    hipError_t e = hipLaunchCooperativeKernel((const void*)mega, dim3(grid_blocks), dim3(NT), args, LDS_BYTES, stream);
    if (e != hipSuccess) fprintf(stderr, "cooperative launch failed: %s (grid %d)\n", hipGetErrorString(e), grid_blocks);
}
```

```cpp
#include <hip/hip_runtime.h>
#include <hip/hip_cooperative_groups.h>
#include <stdint.h>
#include <stdio.h>
namespace cg = cooperative_groups;

#ifndef PROBE
#define PROBE 0
#endif
#ifndef EN_A
#define EN_A 1
#endif
#ifndef EN_B
#define EN_B 1
#endif
#ifndef EN_C
#define EN_C 1
#endif
#ifndef EN_D
#define EN_D 1
#endif

typedef unsigned short bf16;
typedef short bf16x8 __attribute__((ext_vector_type(8)));
typedef float f32x16 __attribute__((ext_vector_type(16)));
typedef float f32x4 __attribute__((ext_vector_type(4)));
typedef unsigned u32x4 __attribute__((ext_vector_type(4)));
typedef unsigned u32x2 __attribute__((ext_vector_type(2)));

constexpr int NT = 512;
constexpr int NB = 8, LAT = 4096, CTX = 256, DM = 1024, DEPTH = 4;
constexpr int MLAT = NB * LAT, MCTX = NB * CTX, MROWS = MLAT + MCTX, DIN = 3712;
constexpr int SKV = CTX + LAT;
constexpr int NFFT = 8192;

constexpr size_t MiB = 1u << 20;
constexpr size_t WS_CTL = 0;
constexpr size_t WS_MODV = 1 * MiB;
constexpr size_t WS_TW = 2 * MiB;
constexpr size_t WS_ROPE = 3 * MiB;
constexpr size_t WS_H2 = 4 * MiB;
constexpr size_t WS_HCTX = 6 * MiB;
constexpr size_t WS_WINT = 7 * MiB;
constexpr size_t WS_WOUTT = 15 * MiB;
constexpr size_t WS_CTXS = 17 * MiB;
constexpr size_t WS_KHAT = 25 * MiB;
constexpr size_t KHAT_COPY = 16 * MiB;
constexpr size_t WS_VTW = 57 * MiB;
constexpr size_t WS_VTF = 66 * MiB;
constexpr size_t WS_HMIX = 75 * MiB;
constexpr size_t WS_ZHY = 143 * MiB;
constexpr size_t WS_ZRW = 194 * MiB;
constexpr size_t WS_MIX = WS_ZHY;
constexpr size_t WS_YF = WS_MIX + 68 * MiB;
constexpr size_t WS_YB = WS_YF + 17 * MiB;
static_assert(WS_YB + 17 * MiB <= 254 * MiB, "Y overlay");
constexpr size_t HYT_CTX_OFF = (size_t)NB * 4 * 256 * LAT;
constexpr size_t WS_ZWA = 254 * MiB;
constexpr size_t WS_ZFA = 280 * MiB;
constexpr size_t WS_GATES = 306 * MiB;
constexpr size_t WS_RW = 374 * MiB;
constexpr size_t RW_STRIDE = 17 * MiB;
constexpr size_t WS_WINT2 = WS_RW + 7 * RW_STRIDE;
constexpr size_t WS_WOUTT2 = WS_WINT2 + 8 * MiB;
constexpr size_t WS_HCTX2 = WS_WOUTT2 + 2 * MiB;
constexpr size_t WS_HRAW = WS_HCTX2 + 1 * MiB;
constexpr size_t WS_END = WS_HRAW + 8 * MiB;
constexpr size_t WS_HRAWC = 5 * MiB + 256 * 1024;
static_assert(WS_END <= 512 * MiB, "workspace");
static_assert((size_t)MROWS * 256 * 2 <= RW_STRIDE, "rw stride");

constexpr int LDS_BYTES = 144 * 1024;

typedef __attribute__((address_space(1))) const float* gcfp;
typedef __attribute__((address_space(1))) float* gfp;
typedef __attribute__((address_space(1))) unsigned char* gu8p;
typedef const gcfp __attribute__((address_space(4)))* intab_t;
struct InTab { intab_t t; __device__ __forceinline__ const float* operator[](int i) const { return (const float*)t[i]; } };
struct P { InTab in; float* out; unsigned char* ws; };
struct KP { const float* in[31]; float* out; unsigned char* ws; };
#define FENCE(q) do { gu8p w_ = (gu8p)q.ws; gfp o_ = (gfp)q.out; asm volatile("" : "+s"(w_), "+s"(o_), "+s"(q.in.t)); q.ws = (unsigned char*)w_; q.out = (float*)o_; } while (0)
enum { I_X = 0, I_C, I_CTX, I_CCTX, I_MODW, I_MODB, I_NORMG, I_WIN, I_WOUT, I_HYCONV, I_HYFW1, I_HYFB1, I_HYFREQ, I_HYFW2, I_HYFB2, I_HYFW3,
       I_HYBIAS, I_RWCONV, I_RWW0, I_RWWUP, I_RWA0, I_RWAUP, I_RWKK, I_RWKA, I_RWRK, I_RWLNG, I_RWLNB, I_WASINK, I_FAQN, I_FAKN, I_FINALG };

__device__ __forceinline__ bf16 f2bf(float f) { unsigned u = __float_as_uint(f); return (bf16)((u + 0x7fffu + ((u >> 16) & 1u)) >> 16); }
__device__ __forceinline__ float bf2f(bf16 h) { return __uint_as_float(((unsigned)h) << 16); }
__device__ __forceinline__ unsigned pk2(float lo, float hi) { return (unsigned)f2bf(lo) | ((unsigned)f2bf(hi) << 16); }
__device__ __forceinline__ unsigned cvtpk(float lo, float hi) { unsigned r; asm volatile("v_cvt_pk_bf16_f32 %0, %1, %2" : "=v"(r) : "v"(lo), "v"(hi)); return r; }
__device__ __forceinline__ bf16 cvt1(float x) { return __builtin_bit_cast(unsigned short, (__bf16)x); }
__device__ __forceinline__ float bflo(unsigned u) { return __uint_as_float(u << 16); }
__device__ __forceinline__ float bfhi(unsigned u) { return __uint_as_float(u & 0xffff0000u); }
__device__ __forceinline__ float sum8(float x) {
    x += __int_as_float(__builtin_amdgcn_update_dpp(0, __float_as_int(x), 0xB1, 0xF, 0xF, true));
    x += __int_as_float(__builtin_amdgcn_update_dpp(0, __float_as_int(x), 0x4E, 0xF, 0xF, true));
    x += __int_as_float(__builtin_amdgcn_update_dpp(0, __float_as_int(x), 0x141, 0xF, 0xF, true));
    return x;
}
__device__ __forceinline__ float ftanh(float x) { const float e = __expf(-2.0f * fabsf(x)); const float t = (1.0f - e) * __builtin_amdgcn_rcpf(1.0f + e); return x < 0.f ? -t : t; }
__device__ __forceinline__ float siluf(float x) { return x / (1.0f + __expf(-x)); }
__device__ __forceinline__ int tidx() { int t = threadIdx.x; asm volatile("" : "+v"(t)); return t; }
__device__ __forceinline__ float wave_sum(float v) {
#pragma unroll
    for (int o = 1; o < 64; o <<= 1) v += __shfl_xor(v, o);
    return v;
}
__device__ __forceinline__ float red_rev(float x) { float r = x * 0.15915494309189535f; return r - rintf(r); }
__device__ __forceinline__ float fsin(float x) { return __builtin_amdgcn_sinf(red_rev(x)); }
__device__ __forceinline__ float fcos(float x) { return __builtin_amdgcn_cosf(red_rev(x)); }
__device__ __forceinline__ int row_lat(int b, int t) { return b * LAT + t; }
__device__ __forceinline__ int row_ctx(int b, int t) { return MLAT + b * CTX + t; }

__device__ __forceinline__ void ph_modv(const P& p, unsigned char* smem, int bid, int nblk) {
    float* sc = (float*)smem;
    float* red = sc + 9 * 1024;
    const float* c = p.in[I_C]; const float* cc = p.in[I_CCTX];
    const int tid = tidx();
    for (int i = tid; i < 9 * 1024; i += NT) { float v = (i < 8192) ? c[i] : cc[i - 8192]; sc[i] = siluf(v); }
    __syncthreads();
    const int nl = tid % 48, kg = tid / 48;
    for (int chunk = bid; chunk < 256; chunk += nblk) {
        const int l = chunk >> 6, n = (chunk & 63) * 48 + nl;
        float acc[9];
#pragma unroll
        for (int i = 0; i < 9; ++i) acc[i] = 0.f;
        if (kg < 10) {
            const float* W = p.in[I_MODW] + (size_t)l * 1024 * 3072 + n;
#pragma unroll 8
            for (int k = kg; k < 1024; k += 10) {
                float w = W[(size_t)k * 3072];
#pragma unroll
                for (int i = 0; i < 9; ++i) acc[i] += sc[i * 1024 + k] * w;
            }
#pragma unroll
            for (int i = 0; i < 9; ++i) red[(kg * 9 + i) * 48 + nl] = acc[i];
        }
        __syncthreads();
        if (tid < 432) {
            const int i = tid / 48, n2 = (chunk & 63) * 48 + (tid % 48);
            float sum = p.in[I_MODB][l * 3072 + n2];
#pragma unroll
            for (int g = 0; g < 10; ++g) sum += red[(g * 9 + i) * 48 + (tid % 48)];
            ((float*)(p.ws + WS_MODV))[(size_t)l * 9 * 3072 + i * 3072 + n2] = sum;
        }
        __syncthreads();
    }
}

__device__ __forceinline__ void ph_tables(const P& p, int bid, int nblk) {
    for (int gid = bid * NT + tidx(); gid < 4096; gid += nblk * NT) {
        float rev = (float)gid * (1.0f / 8192.0f);
        ((float2*)(p.ws + WS_TW))[gid] = make_float2(__builtin_amdgcn_cosf(rev), -__builtin_amdgcn_sinf(rev));
    }
    for (int i = bid * NT + tidx(); i < 4096 * 32; i += nblk * NT) {
        int pos = i >> 5, sf = i & 31, s = sf >> 4, f = sf & 15;
        float inv = exp2f(-(float)f * (13.287712379549449f / 16.0f));
        float ang = (float)(s == 0 ? (pos >> 6) : (pos & 63)) * inv;
        ((float2*)(p.ws + WS_ROPE))[i] = make_float2(fcos(ang), fsin(ang));
    }
}

__device__ __forceinline__ void transpose_tile(const float* W, int N, bf16* WT, int tile, float* sm  ) {
    int ntn = N / 64; int kt = tile / ntn, nt = tile % ntn; int k0 = kt * 64, n0 = nt * 64;
    for (int i = 0; i < 4096 / NT; ++i) { int idx = i * NT + tidx(); int r = idx >> 6, c = idx & 63; sm[r * 65 + c] = W[(size_t)(k0 + r) * N + n0 + c]; }
    __syncthreads();
    for (int i = 0; i < 4096 / NT; ++i) { int idx = i * NT + tidx(); int n = idx >> 6, k = idx & 63; WT[(size_t)(n0 + n) * 1024 + k0 + k] = f2bf(sm[k * 65 + n]); }
    __syncthreads();
}
__device__ __forceinline__ void ph_wconv(const P& p, int l, unsigned char* smem, int bid, int nblk) {
    float* sm = (float*)smem;
    const int T1 = 16 * (DIN / 64), T2 = 16 * 16;
    for (int t = bid; t < T1 + T2; t += nblk) {
        if (t < T1) transpose_tile(p.in[I_WIN] + (size_t)l * 1024 * DIN, DIN, (bf16*)(p.ws + ((l & 1) ? WS_WINT2 : WS_WINT)), t, sm);
        else transpose_tile(p.in[I_WOUT] + (size_t)l * 1024 * 1024, 1024, (bf16*)(p.ws + ((l & 1) ? WS_WOUTT2 : WS_WOUTT)), t - T1, sm);
    }
}

__device__ __forceinline__ void ph_norm(const P& p, int l, int bid, int nblk) {
    const int lane = tidx() & 63, wave = tidx() >> 6;
    const float* modv = (const float*)(p.ws + WS_MODV) + (size_t)l * 9 * 3072;
    const float* g = p.in[I_NORMG] + l * 1024;
    bf16* H = (bf16*)(p.ws + WS_HMIX);
    for (int m = bid * 8 + wave; m < MROWS; m += nblk * 8) {
        const float* src; int mi;
        if (m < MLAT) { src = (l == 0 ? p.in[I_X] : p.out) + (size_t)m * 1024; mi = m / LAT; }
        else { src = (l == 0 ? p.in[I_CTX] : (const float*)(p.ws + WS_CTXS)) + (size_t)(m - MLAT) * 1024; mi = 8; }
        const float* mv = modv + mi * 3072;
        f32x4 v[4]; float s = 0.f;
#pragma unroll
        for (int j = 0; j < 4; ++j) { v[j] = *(const f32x4*)(src + 256 * j + 4 * lane); s += v[j].x * v[j].x + v[j].y * v[j].y + v[j].z * v[j].z + v[j].w * v[j].w; }
        s = wave_sum(s);
        float rs = rsqrtf(s * (1.0f / 1024.0f) + 1e-6f);
#pragma unroll
        for (int j = 0; j < 4; ++j) {
            int c0 = 256 * j + 4 * lane;
            f32x4 gg = *(const f32x4*)(g + c0), sh = *(const f32x4*)(mv + c0), sc = *(const f32x4*)(mv + 1024 + c0);
            float o0 = v[j].x * rs * gg.x * (1.f + sc.x) + sh.x, o1 = v[j].y * rs * gg.y * (1.f + sc.y) + sh.y;
            float o2 = v[j].z * rs * gg.z * (1.f + sc.z) + sh.z, o3 = v[j].w * rs * gg.w * (1.f + sc.w) + sh.w;
            u32x2 w; w.x = pk2(o0, o1); w.y = pk2(o2, o3);
            *(u32x2*)(H + (size_t)m * 1024 + c0) = w;
        }
    }
}

__device__ __forceinline__ void ph_hy_mlp(const P& p, int l, unsigned char* smem, int bid, int nblk) {
    float (*z)[36] = (float (*)[36])smem; float (*h1)[64] = (float (*)[64])(smem + 8 * 36 * 4);
    const int j = tidx() & 63, rr = tidx() >> 6;
    const float* fw1 = p.in[I_HYFW1] + l * 33 * 64; const float* fb1 = p.in[I_HYFB1] + l * 64; const float* fq = p.in[I_HYFREQ] + l * 64;
    const float* fw2 = p.in[I_HYFW2] + l * 64 * 64; const float* fb2 = p.in[I_HYFB2] + l * 64;
    float* H2 = (float*)(p.ws + WS_H2);
    if (bid * 8 >= 4352) return;
    float w1[33], w2[64];
#pragma unroll
    for (int i = 0; i < 33; ++i) w1[i] = fw1[i * 64 + j];
#pragma unroll
    for (int i = 0; i < 64; ++i) w2[i] = fw2[i * 64 + j];
    const float b1 = fb1[j], b2 = fb2[j], fqj = fq[j];
    for (int r0 = bid * 8; r0 < 4352; r0 += nblk * 8) {
        int row = r0 + rr; int L = row < 4096 ? 4096 : 256; int t = row < 4096 ? row : row - 4096;
        if (j < 33) {
            float val;
            if (j == 0) val = (float)t / (float)(L - 1);
            else { int jj = (j - 1) & 15; float f = 1e-4f + (float)jj * ((15.0f - 1e-4f) / 15.0f); float w = (6.283185307179586f / (float)L) * (float)t; float a = f * w; val = (j <= 16) ? fcos(a) : fsin(a); }
            z[rr][j] = val;
        }
        __syncthreads();
        float a = b1;
#pragma unroll
        for (int i = 0; i < 33; ++i) a += z[rr][i] * w1[i];
        h1[rr][j] = fsin(fqj * a);
        __syncthreads();
        float b = b2;
#pragma unroll
        for (int i = 0; i < 64; ++i) b += h1[rr][i] * w2[i];
        H2[(size_t)row * 64 + j] = fsin(fqj * b);
        __syncthreads();
    }
}

#define PADI(i) ((i) + ((i) >> 5))
constexpr int XLEN = NFFT + NFFT / 32;
__device__ __forceinline__ float2 cmul(float2 a, float2 b) { return make_float2(a.x * b.x - a.y * b.y, a.x * b.y + a.y * b.x); }
__device__ __forceinline__ float2 cmulc(float2 a, float2 b) { return make_float2(a.x * b.x + a.y * b.y, a.y * b.x - a.x * b.y); }

#define C8_RE(k) ((k) == 0 ? 1.0f : (k) == 1 ? 0.9238795325112867f : (k) == 2 ? 0.7071067811865476f : (k) == 3 ? 0.3826834323650898f : (k) == 4 ? 0.0f : (k) == 5 ? -0.3826834323650898f : (k) == 6 ? -0.7071067811865476f : -0.9238795325112867f)
#define C8_IM(k) ((k) == 0 ? 0.0f : (k) == 1 ? -0.3826834323650898f : (k) == 2 ? -0.7071067811865476f : (k) == 3 ? -0.9238795325112867f : (k) == 4 ? -1.0f : (k) == 5 ? -0.9238795325112867f : (k) == 6 ? -0.7071067811865476f : -0.3826834323650898f)
template <int PB, bool INV>
__device__ __forceinline__ void fft_pass(float2* X, const float2* twA, const float2* twB) {
    constexpr int NS = 4, R = 16;
    const int g = tidx();
    const int base_lo = g & ((1 << PB) - 1), base_hi = (g >> PB) << (PB + NS);
    float2 v[R];
#pragma unroll
    for (int j = 0; j < R; ++j) v[j] = X[PADI(base_hi | (j << PB) | base_lo)];
    float2 wb[4];
    if (PB == 9) wb[3] = twA[base_lo];
    else if (PB == 5) wb[3] = twB[base_lo];
    else wb[3] = base_lo ? make_float2(0.9807852804032304f, -0.19509032201612825f) : make_float2(1.0f, 0.0f);
#pragma unroll
    for (int q = 2; q >= 0; --q) wb[q] = make_float2(wb[q + 1].x * wb[q + 1].x - wb[q + 1].y * wb[q + 1].y, 2.0f * wb[q + 1].x * wb[q + 1].y);
#pragma unroll
    for (int qq = 0; qq < NS; ++qq) {
        const int q = INV ? qq : (NS - 1 - qq);
        float2 tws[8];
#pragma unroll
        for (int jl = 0; jl < (1 << q); ++jl) {
            const int k = jl << (3 - q);
            tws[jl] = (k == 0) ? wb[q] : cmul(wb[q], make_float2(C8_RE(k), C8_IM(k)));
        }
#pragma unroll
        for (int j = 0; j < R; ++j) {
            if (j & (1 << q)) continue;
            const int j2 = j | (1 << q);
            const float2 tw = tws[j & ((1 << q) - 1)];
            if (!INV) {
                float2 a = v[j], b = v[j2];
                v[j] = make_float2(a.x + b.x, a.y + b.y);
                v[j2] = cmul(make_float2(a.x - b.x, a.y - b.y), tw);
            } else {
                float2 a = v[j], b = cmulc(v[j2], tw);
                v[j] = make_float2(a.x + b.x, a.y + b.y);
                v[j2] = make_float2(a.x - b.x, a.y - b.y);
            }
        }
    }
#pragma unroll
    for (int j = 0; j < R; ++j) X[PADI(base_hi | (j << PB) | base_lo)] = v[j];
    __syncthreads();
}
__device__ __forceinline__ void fft_load_tw(float2* twA, const float2* twg) {
    const int t = tidx();
    twA[t] = twg[t];
    if (t < 32) twA[512 + t] = twg[16 * t];
}
__device__ __forceinline__ void fft_fwd_hi(float2* X, const float2* twA) { fft_pass<9, false>(X, twA, twA + 512); fft_pass<5, false>(X, twA, twA + 512); fft_pass<1, false>(X, twA, twA + 512); }
__device__ __forceinline__ void fft_inv_hi(float2* X, const float2* twA) { fft_pass<1, true>(X, twA, twA + 512); fft_pass<5, true>(X, twA, twA + 512); fft_pass<9, true>(X, twA, twA + 512); }

__device__ __forceinline__ void ph_hraw(const P& p, int l, int bid, int nblk) {
    const int tid = tidx(), lane = tid & 63, wave = tid >> 6, r = lane & 31, hh = lane >> 5;
    const float* H2 = (const float*)(p.ws + WS_H2);
    const float* fw3 = p.in[I_HYFW3] + (size_t)l * 64 * 1024;
    bf16* HR = (bf16*)(p.ws + WS_HRAW); bf16* HRC = (bf16*)(p.ws + WS_HRAWC);
    const int gw = bid * 8 + wave, nw = nblk * 8;
    const int ct = gw & 31;
    bf16x8 Af[4];
#pragma unroll
    for (int sI = 0; sI < 4; ++sI) {
        const float* u0 = fw3 + (size_t)(16 * sI + 8 * hh) * 1024 + ct * 32 + r;
        u32x4 w; w.x = cvtpk(u0[0], u0[1024]); w.y = cvtpk(u0[2048], u0[3072]); w.z = cvtpk(u0[4096], u0[5120]); w.w = cvtpk(u0[6144], u0[7168]);
        Af[sI] = __builtin_bit_cast(bf16x8, w);
    }
    for (int tt = gw >> 5; tt < 136; tt += nw >> 5) {
        const int t0 = tt * 32;
        f32x16 acc;
#pragma unroll
        for (int e = 0; e < 16; ++e) acc[e] = 0.f;
#pragma unroll
        for (int sI = 0; sI < 4; ++sI) {
            const float* hp = H2 + (size_t)(t0 + r) * 64 + 16 * sI + 8 * hh;
            const f32x4 h0 = *(const f32x4*)hp, h1 = *(const f32x4*)(hp + 4);
            u32x4 w; w.x = cvtpk(h0.x, h0.y); w.y = cvtpk(h0.z, h0.w); w.z = cvtpk(h1.x, h1.y); w.w = cvtpk(h1.z, h1.w);
            acc = __builtin_amdgcn_mfma_f32_32x32x16_bf16(Af[sI], __builtin_bit_cast(bf16x8, w), acc, 0, 0, 0);
        }
#pragma unroll
        for (int e = 0; e < 16; ++e) {
            const int col = ct * 32 + (e & 3) + 8 * (e >> 2) + 4 * hh, t = t0 + r;
            if (t < 4096) HR[(size_t)col * 4096 + t] = cvt1(acc[e]);
            else HRC[(size_t)col * 256 + (t - 4096)] = cvt1(acc[e]);
        }
    }
}

__device__ __forceinline__ void hy_filt_task(const P& p, int l, int task, unsigned char* smem) {
    float2* X = (float2*)smem;
    float* red = (float*)(smem + XLEN * 8);
    float2* tw = (float2*)(red + 8 + 128);
    fft_load_tw(tw, (const float2*)(p.ws + WS_TW));
    const bf16* HR = (const bf16*)(p.ws + WS_HRAW); const bf16* HRC = (const bf16*)(p.ws + WS_HRAWC);
    const int tid = tidx();
    {
        const bool isctx = task >= 512; const int oc = task & 511, o = oc >> 8, c = oc & 255;
        const float delta = fabsf(-3.0701134573253945f + (float)c * ((-15.350567286626973f + 3.0701134573253945f) / 255.0f));
        float asum = 0.f; float hf0 = 0.f, hb0 = 0.f;
        if (isctx) {
            if (tid < 256) {
                const float dec = __expf(-((float)tid / 255.0f) * delta);
                hf0 = bf2f(HRC[(size_t)(o * 512 + c) * 256 + tid]) * dec; hb0 = bf2f(HRC[(size_t)(o * 512 + 256 + c) * 256 + tid]) * dec;
                asum = fabsf(hf0) + fabsf(hb0);
            }
        } else {
            const int t0 = tid * 8;
            const u32x4 fv = *(const u32x4*)(HR + (size_t)(o * 512 + c) * 4096 + t0), bv = *(const u32x4*)(HR + (size_t)(o * 512 + 256 + c) * 4096 + t0);
#pragma unroll
            for (int j = 0; j < 8; ++j) {
                const int t = t0 + j;
                const float dec = __expf(-((float)t * (1.0f / 4095.0f)) * delta);
                const float a = ((j & 1) ? bfhi(fv[j >> 1]) : bflo(fv[j >> 1])) * dec, b = ((j & 1) ? bfhi(bv[j >> 1]) : bflo(bv[j >> 1])) * dec;
                asum += fabsf(a) + fabsf(b);
                X[PADI(t)] = make_float2(a, 0.f);
                const int m2 = (t == 0) ? 4096 : (NFFT - t);
                X[PADI(m2)] = make_float2(t == 0 ? 0.f : b, 0.f);
            }
        }
        asum = wave_sum(asum);
        if ((tid & 63) == 0) red[tid >> 6] = asum;
        __syncthreads();
        float tot = 0.f;
#pragma unroll
        for (int i = 0; i < 8; ++i) tot += red[i];
        const float inv = 1.0f / tot;
        if (isctx) {
            float* HC = (float*)(p.ws + ((l & 1) ? WS_HCTX2 : WS_HCTX));
            if (tid < 256) { HC[((o * 2 + 0) * 256 + c) * 256 + tid] = hf0 * inv; HC[((o * 2 + 1) * 256 + c) * 256 + tid] = hb0 * inv; }
            __syncthreads();
            return;
        }
        const float sc = inv * (1.0f / (float)NFFT);
        __syncthreads();
        fft_fwd_hi(X, tw);
        unsigned* KH = (unsigned*)(p.ws + WS_KHAT + (size_t)(l & 1) * KHAT_COPY) + (size_t)oc * NFFT;
        for (int i = 0; i < 8; ++i) {
            int pidx = tid + NT * i; float2 a = X[PADI(2 * pidx)], b = X[PADI(2 * pidx + 1)];
            u32x2 w; w.x = cvtpk((a.x + b.x) * sc, (a.y + b.y) * sc); w.y = cvtpk((a.x - b.x) * sc, (a.y - b.y) * sc);
            *(u32x2*)(KH + 2 * pidx) = w;
        }
        __syncthreads();
    }
}

__device__ __forceinline__ void ph_hy_filt(const P& p, int l, unsigned char* smem, int bid, int nblk) {
    unsigned* ctr = (unsigned*)(p.ws + WS_CTL) + 64 * (8 + l);
    volatile int* s_task = (volatile int*)(smem + LDS_BYTES - 16);
    for (;;) {
        __syncthreads();
        if (tidx() == 0) *s_task = (int)atomicAdd(ctr, 1u);
        __syncthreads();
        const int task = __builtin_amdgcn_readfirstlane(*s_task);
        if (task >= 1024) break;
        hy_filt_task(p, l, task, smem);
    }
}
namespace pg8 {
#define PG8_LAS __attribute__((address_space(3)))
typedef unsigned short bf16_t;
typedef short bf16x8 __attribute__((ext_vector_type(8)));
typedef float f32x4 __attribute__((ext_vector_type(4)));
typedef unsigned u32x4 __attribute__((ext_vector_type(4)));
constexpr int BM = 256, BK = 64, HALF = 128, HTB = HALF * BK * 2  , STAGE_BYTES = 8 * HTB, NXCD = 8, WGM = 8;

__host__ __device__ __forceinline__ int lds_byte(int r, int c) { const int st = (r >> 4) * 2 + (c >> 5), rr = r & 15, cc = c & 31, ob = rr * 64 + cc * 2; return st * 1024 + (ob ^ (((ob >> 9) & 1) << 5)); }
__host__ __device__ __forceinline__ void stage_rc(int b, int& R, int& C) { const int st = b / 1024, sb = b % 1024, swz = sb ^ (((sb >> 9) & 1) << 5); R = (st >> 1) * 16 + swz / 64; C = (st & 1) * 32 + (swz % 64) / 2; }
__host__ __device__ __forceinline__ int perm32(int rho) { const int n = rho >> 4, i = rho & 15; return 8 * (i >> 2) + 4 * n + (i & 3); }

struct Unit { int pm, pn; };
struct Gemm { const bf16_t* A; const bf16_t* Bt; int M, N, K; };

struct StaticOrder {
    int nM, nN, nwg, G, c;
    __host__ __device__ void init(int M, int N, int G_, int c_) { nM = M / BM; nN = N / BM; nwg = nM * nN; G = G_; c = c_; }
    __host__ __device__ bool next(int i, Unit& u) const {
        const long L = (long)i * G + c; if (L >= nwg) return false;
        int wgid = (int)L; { const int q = nwg / NXCD, r = nwg % NXCD, xcd = wgid % NXCD, off = wgid / NXCD; wgid = (xcd < r ? xcd * (q + 1) : r * (q + 1) + (xcd - r) * q) + off; }
        const int nig = WGM * nN, gid = wgid / nig, fm = gid * WGM, gsz = (nM - fm) < WGM ? (nM - fm) : WGM;
        u.pm = fm + ((wgid % nig) % gsz); u.pn = (wgid % nig) / gsz; return true;
    }
    __device__ __forceinline__ void a_ready(const Unit&) const {}
    __device__ __forceinline__ void done(const Unit&) const {}
};
struct OneUnit {
    int pm, pn;
    __host__ __device__ bool next(int i, Unit& u) const { if (i != 0) return false; u.pm = pm; u.pn = pn; return true; }
    __device__ __forceinline__ void a_ready(const Unit&) const {}
    __device__ __forceinline__ void done(const Unit&) const {}
};
__device__ __forceinline__ unsigned cvt_pk_bf16(float lo, float hi) { unsigned r; asm volatile("v_cvt_pk_bf16_f32 %0, %1, %2" : "=v"(r) : "v"(lo), "v"(hi)); return r; }
template <class Epi, class Sched, bool ALIGN_EPI = false, bool SP2 = false>
__device__ __forceinline__ void gemm_phase(PG8_LAS unsigned char* lds, const Gemm g, const Sched& S, const Epi& E) {
    const int tid = tidx(), wid = __builtin_amdgcn_readfirstlane(tid >> 6), lane = tid & 63, wr = wid >> 2, wc = wid & 3, fr = lane & 15, fq = lane >> 4;
    const int K = g.K, nt = K / BK;
    unsigned voffA[2], voffB[2];
#pragma unroll
    for (int i = 0; i < 2; ++i) { int R, C; stage_rc(tid * 16 + i * 8192, R, C); const int Rb = Epi::PERM ? ((R & ~31) + perm32(R & 31)) : R;
        voffA[i] = (unsigned)(R * K + C) * 2u; voffB[i] = (unsigned)(Rb * K + C) * 2u; }
    const size_t kstep = (size_t)(BK * 2);
    const size_t hstep = (size_t)HALF * K * 2;
    const size_t tstep = 2 * hstep;
    const unsigned ldsw = (unsigned)wid * 1024u;
    const int aoff = lds_byte(wr * 64 + fr, fq * 8), boff = lds_byte(wc * 32 + fr, fq * 8);
#define PG8_SA(b, h) (((b) * 2 + (h)) * HTB)
#define PG8_SB(b, h) ((4 + (b) * 2 + (h)) * HTB)
#define PG8_STAGE(bufoff, gbase, voff) do { _Pragma("unroll") for (int _i = 0; _i < 2; ++_i) \
        __builtin_amdgcn_global_load_lds((const unsigned*)((const char*)(gbase) + (voff)[_i]), (PG8_LAS unsigned*)(lds + (bufoff) + ldsw + _i * 8192), 16, 0, 0); } while (0)
#define PG8_LDA(dst, b, h) do { _Pragma("unroll") for (int m = 0; m < 4; ++m) _Pragma("unroll") for (int k = 0; k < 2; ++k) dst[m][k] = *(const PG8_LAS bf16x8*)(lds + PG8_SA(b, h) + aoff + m * 2048 + k * 1024); } while (0)
#define PG8_LDB(dst, b, h) do { _Pragma("unroll") for (int n = 0; n < 2; ++n) _Pragma("unroll") for (int k = 0; k < 2; ++k) dst[n][k] = *(const PG8_LAS bf16x8*)(lds + PG8_SB(b, h) + boff + n * 2048 + k * 1024); } while (0)
#define PG8_MMA(ai, bj, At, Bt) do { __builtin_amdgcn_s_setprio(1); _Pragma("unroll") for (int m = 0; m < 4; ++m) _Pragma("unroll") for (int n = 0; n < 2; ++n) _Pragma("unroll") for (int k = 0; k < 2; ++k) \
        acc[ai][bj][m][n] = __builtin_amdgcn_mfma_f32_16x16x32_bf16(Bt[n][k], At[m][k], acc[ai][bj][m][n], 0, 0, 0); __builtin_amdgcn_s_setprio(0); } while (0)
#define PG8_WAIT_V(n) asm volatile("s_waitcnt vmcnt(" #n ")" ::: "memory")
#define PG8_WAIT_L(n) asm volatile("s_waitcnt lgkmcnt(" #n ")" ::: "memory")
#define PG8_BAR __builtin_amdgcn_s_barrier()
#define PG8_SCHED __builtin_amdgcn_sched_barrier(0)
    Unit cur, nxt; int ui = 0;
    if (!S.next(0, cur)) return;
    f32x4 acc[2][2][4][2];
#pragma unroll
    for (int a = 0; a < 2; ++a)
#pragma unroll
        for (int b = 0; b < 2; ++b)
#pragma unroll
            for (int m = 0; m < 4; ++m)
#pragma unroll
                for (int n = 0; n < 2; ++n) acc[a][b][m][n] = (f32x4){0.f, 0.f, 0.f, 0.f};
    bf16x8 At[4][2], B0[2][2], B1[2][2];
    const char* cA = (const char*)g.A + (size_t)cur.pm * tstep; const char* cB = (const char*)g.Bt + (size_t)cur.pn * tstep;
    S.a_ready(cur);
    if constexpr (SP2) {
        PG8_STAGE(PG8_SB(0, 0), cB, voffB); PG8_STAGE(PG8_SB(0, 1), cB + hstep, voffB); PG8_STAGE(PG8_SA(0, 0), cA, voffA); PG8_STAGE(PG8_SA(0, 1), cA + hstep, voffA);
        if (wr == 1) PG8_BAR;
        PG8_WAIT_V(2); PG8_BAR;
        PG8_STAGE(PG8_SB(1, 0), cB + kstep, voffB); PG8_STAGE(PG8_SA(1, 0), cA + kstep, voffA); PG8_STAGE(PG8_SB(1, 1), cB + hstep + kstep, voffB);
        PG8_WAIT_V(6); PG8_BAR;
    } else {
        PG8_STAGE(PG8_SB(0, 0), cB, voffB); PG8_STAGE(PG8_SA(0, 0), cA, voffA); PG8_STAGE(PG8_SB(0, 1), cB + hstep, voffB); PG8_STAGE(PG8_SA(0, 1), cA + hstep, voffA);
        if (wr == 1) PG8_BAR;
        PG8_WAIT_V(4); PG8_BAR;
        PG8_STAGE(PG8_SB(1, 0), cB + kstep, voffB); PG8_STAGE(PG8_SA(1, 0), cA + kstep, voffA); PG8_STAGE(PG8_SB(1, 1), cB + hstep + kstep, voffB);
        PG8_WAIT_V(6); PG8_BAR;
    }
    for (;;) {
        const bool has_next = S.next(ui + 1, nxt);
        const char* nA = has_next ? (const char*)g.A + (size_t)nxt.pm * tstep : cA; const char* nB = has_next ? (const char*)g.Bt + (size_t)nxt.pn * tstep : cB;
        for (int t = 0; t < nt; t += 2) {
            const bool last = (t == nt - 2);
            const char* a1 = cA + (size_t)(t + 1) * kstep;
            const char* a2 = last ? nA : cA + (size_t)(t + 2) * kstep; const char* b2 = last ? nB : cB + (size_t)(t + 2) * kstep;
            const char* a3 = a2 + kstep; const char* b3 = b2 + kstep;
            if (last && has_next) S.a_ready(nxt);
            if constexpr (SP2) {
            PG8_LDB(B0, 0, 0); PG8_LDB(B1, 0, 1); PG8_SCHED; PG8_LDA(At, 0, 0); PG8_STAGE(PG8_SA(1, 1), a1 + hstep, voffA);
            PG8_WAIT_V(8); PG8_WAIT_L(0); PG8_BAR; PG8_MMA(0, 0, At, B0); PG8_MMA(0, 1, At, B1); PG8_BAR; PG8_SCHED;
            PG8_LDA(At, 0, 1); PG8_STAGE(PG8_SB(0, 0), b2, voffB); PG8_STAGE(PG8_SB(0, 1), b2 + hstep, voffB); PG8_STAGE(PG8_SA(0, 0), a2, voffA);
            PG8_WAIT_V(8); PG8_WAIT_L(0); PG8_BAR; PG8_MMA(1, 0, At, B0); PG8_MMA(1, 1, At, B1); PG8_BAR; PG8_SCHED;
            PG8_LDB(B0, 1, 0); PG8_LDB(B1, 1, 1); PG8_SCHED; PG8_LDA(At, 1, 0); PG8_STAGE(PG8_SA(0, 1), a2 + hstep, voffA);
            PG8_WAIT_V(8); PG8_WAIT_L(0); PG8_BAR; PG8_MMA(0, 0, At, B0); PG8_MMA(0, 1, At, B1); PG8_BAR; PG8_SCHED;
            PG8_LDA(At, 1, 1); PG8_STAGE(PG8_SB(1, 0), b3, voffB); PG8_STAGE(PG8_SB(1, 1), b3 + hstep, voffB); PG8_STAGE(PG8_SA(1, 0), a3, voffA);
            PG8_WAIT_V(8); PG8_WAIT_L(0); PG8_BAR; PG8_MMA(1, 0, At, B0); PG8_MMA(1, 1, At, B1); PG8_BAR; PG8_SCHED;
            } else {
            PG8_LDB(B0, 0, 0); PG8_SCHED; PG8_LDA(At, 0, 0); PG8_STAGE(PG8_SA(1, 1), a1 + hstep, voffA);
            PG8_WAIT_L(8); PG8_BAR; PG8_WAIT_L(0); PG8_MMA(0, 0, At, B0); PG8_BAR; PG8_SCHED;
            PG8_LDB(B1, 0, 1); PG8_STAGE(PG8_SB(0, 0), b2, voffB);
            PG8_BAR; PG8_WAIT_L(0); PG8_MMA(0, 1, At, B1); PG8_BAR;
            PG8_LDA(At, 0, 1); PG8_STAGE(PG8_SA(0, 0), a2, voffA);
            PG8_BAR; PG8_WAIT_L(0); PG8_MMA(1, 0, At, B0); PG8_BAR; PG8_SCHED;
            PG8_STAGE(PG8_SB(0, 1), b2 + hstep, voffB);
            PG8_WAIT_V(6); PG8_BAR; PG8_MMA(1, 1, At, B1); PG8_BAR;
            PG8_LDB(B0, 1, 0); PG8_SCHED; PG8_LDA(At, 1, 0); PG8_STAGE(PG8_SA(0, 1), a2 + hstep, voffA);
            PG8_WAIT_L(8); PG8_BAR; PG8_WAIT_L(0); PG8_MMA(0, 0, At, B0); PG8_BAR; PG8_SCHED;
            PG8_LDB(B1, 1, 1); PG8_STAGE(PG8_SB(1, 0), b3, voffB);
            PG8_BAR; PG8_WAIT_L(0); PG8_MMA(0, 1, At, B1); PG8_BAR;
            PG8_LDA(At, 1, 1); PG8_STAGE(PG8_SA(1, 0), a3, voffA);
            PG8_BAR; PG8_WAIT_L(0); PG8_MMA(1, 0, At, B0); PG8_BAR; PG8_SCHED;
            PG8_STAGE(PG8_SB(1, 1), b3 + hstep, voffB);
            PG8_WAIT_V(6); PG8_BAR; PG8_MMA(1, 1, At, B1); PG8_BAR;
            }
        }
        if constexpr (ALIGN_EPI) { if (wr == 0) PG8_BAR; }
        if constexpr (!Epi::AFTER_DRAIN) { E(acc, cur, wr, wc, fr, fq); S.done(cur); }
        if (!has_next) break;
#pragma unroll
        for (int a = 0; a < 2; ++a)
#pragma unroll
            for (int b = 0; b < 2; ++b)
#pragma unroll
                for (int m = 0; m < 4; ++m)
#pragma unroll
                    for (int n = 0; n < 2; ++n) acc[a][b][m][n] = (f32x4){0.f, 0.f, 0.f, 0.f};
        cur = nxt; cA = nA; cB = nB; ++ui;
        if constexpr (ALIGN_EPI) { if (wr == 1) PG8_BAR; }
    }
    PG8_WAIT_V(0);
    if constexpr (!ALIGN_EPI) { if (wr == 0) PG8_BAR; }
    PG8_BAR;
    if constexpr (Epi::AFTER_DRAIN) { E.fused(acc, cur, wr, wc, fr, fq, lds, wid, lane); S.done(cur); }
#undef PG8_SA
#undef PG8_SB
#undef PG8_STAGE
#undef PG8_LDA
#undef PG8_LDB
#undef PG8_MMA
#undef PG8_WAIT_V
#undef PG8_WAIT_L
#undef PG8_BAR
#undef PG8_SCHED
}
}

struct EpiIn {
    static constexpr bool PERM = true, AFTER_DRAIN = false;
    unsigned char* ws;
    __device__ __forceinline__ void operator()(const pg8::f32x4 (&acc)[2][2][4][2], const pg8::Unit& u, int wr, int wc, int fr, int fq) const {
#pragma unroll
        for (int bj = 0; bj < 2; ++bj) {
            const int tn = u.pn * 2 + bj;
            if (tn >= 29) continue;
            bf16* dst; int pitch, coff; bool vt = false;
            if (tn < 6) { dst = (bf16*)(ws + WS_ZHY); pitch = 768; coff = tn * 128; }
            else if (tn < 8) { dst = (bf16*)(ws + WS_GATES); pitch = 1024; coff = (tn - 6) * 128; }
            else if (tn < 15) { dst = (bf16*)(ws + WS_ZRW); pitch = 896; coff = (tn - 8) * 128; }
            else if (tn < 17) { dst = (bf16*)(ws + WS_GATES); pitch = 1024; coff = 256 + (tn - 15) * 128; }
            else if (tn < 20) { dst = (bf16*)(ws + WS_ZWA); pitch = 384; coff = (tn - 17) * 128; }
            else if (tn == 20) { dst = (bf16*)(ws + WS_VTW); vt = true; pitch = 0; coff = 0; }
            else if (tn < 23) { dst = (bf16*)(ws + WS_GATES); pitch = 1024; coff = 512 + (tn - 21) * 128; }
            else if (tn < 26) { dst = (bf16*)(ws + WS_ZFA); pitch = 384; coff = (tn - 23) * 128; }
            else if (tn == 26) { dst = (bf16*)(ws + WS_VTF); vt = true; pitch = 0; coff = 0; }
            else { dst = (bf16*)(ws + WS_GATES); pitch = 1024; coff = 768 + (tn - 27) * 128; }
            const int cc = wc * 32 + 8 * fq;
#pragma unroll
            for (int ai = 0; ai < 2; ++ai)
#pragma unroll
                for (int m = 0; m < 4; ++m) {
                    const int row = u.pm * 256 + ai * 128 + wr * 64 + m * 16 + fr;
                    const pg8::f32x4 v0 = acc[ai][bj][m][0], v1 = acc[ai][bj][m][1];
                    if (!vt) {
                        u32x4 w; w.x = pg8::cvt_pk_bf16(v0[0], v0[1]); w.y = pg8::cvt_pk_bf16(v0[2], v0[3]); w.z = pg8::cvt_pk_bf16(v1[0], v1[1]); w.w = pg8::cvt_pk_bf16(v1[2], v1[3]);
                        *(u32x4*)(dst + (size_t)row * pitch + coff + cc) = w;
                    } else {
                        int bb, key;
                        if (row < MLAT) { bb = row / LAT; key = CTX + (row % LAT); } else { bb = (row - MLAT) / CTX; key = (row - MLAT) % CTX; }
                        bf16* o = dst + ((size_t)(bb * 2 + (cc >> 6)) * 64 + (cc & 63)) * SKV + key;
                        o[0 * SKV] = f2bf(v0[0]); o[1 * SKV] = f2bf(v0[1]); o[2 * SKV] = f2bf(v0[2]); o[3 * SKV] = f2bf(v0[3]);
                        o[4 * SKV] = f2bf(v1[0]); o[5 * SKV] = f2bf(v1[1]); o[6 * SKV] = f2bf(v1[2]); o[7 * SKV] = f2bf(v1[3]);
                    }
                }
        }
    }
};
struct EpiOut {
    static constexpr bool PERM = false, AFTER_DRAIN = false;
    const float* xin_lat; const float* xin_ctx; float* out_lat; float* out_ctx; const float* gate;
    __device__ __forceinline__ void operator()(const pg8::f32x4 (&acc)[2][2][4][2], const pg8::Unit& u, int wr, int wc, int fr, int fq) const {
#pragma unroll
        for (int ai = 0; ai < 2; ++ai)
#pragma unroll
            for (int m = 0; m < 4; ++m) {
                const int row = u.pm * 256 + ai * 128 + wr * 64 + m * 16 + fr;
                const float* src; float* dst; const float* g;
                if (row < MLAT) { src = xin_lat + (size_t)row * 1024; dst = out_lat + (size_t)row * 1024; g = gate + (row / LAT) * 3072; }
                else { src = xin_ctx + (size_t)(row - MLAT) * 1024; dst = out_ctx + (size_t)(row - MLAT) * 1024; g = gate + 8 * 3072; }
#pragma unroll
                for (int bj = 0; bj < 2; ++bj)
#pragma unroll
                    for (int n = 0; n < 2; ++n) {
                        const int c = u.pn * 256 + bj * 128 + wc * 32 + n * 16 + 4 * fq;
                        const pg8::f32x4 x = *(const pg8::f32x4*)(src + c), gg = *(const pg8::f32x4*)(g + c);
                        *(pg8::f32x4*)(dst + c) = x + gg * acc[ai][bj][m][n];
                    }
            }
    }
};

constexpr int LOWLD = 136;
__device__ __forceinline__ void ph_rw_prep(const P& p, int l, unsigned char* smem, int bid, int nblk) {
    const int tid = tidx(), lane = tid & 63, wave = __builtin_amdgcn_readfirstlane(tid >> 6), r = lane & 31, hh = lane >> 5;
    bf16* lowA = (bf16*)smem;
    const bf16* Z = (const bf16*)(p.ws + WS_ZRW);
    const float* cw = p.in[I_RWCONV] + (size_t)l * 3 * 896;
    bf16* RWb = (bf16*)(p.ws + WS_RW);
    const size_t AS = RW_STRIDE / 2;
    const int mtx = wave >> 1, nb = (wave & 1) * 128;
    const float* up = (mtx < 2 ? p.in[I_RWWUP] : p.in[I_RWAUP]) + (size_t)l * 2 * 64 * 256 + (size_t)(mtx & 1) * 64 * 256;
    bf16x8 Bf[4][4];
#pragma unroll
    for (int nt = 0; nt < 4; ++nt)
#pragma unroll
        for (int sI = 0; sI < 4; ++sI) {
            const float* u0 = up + (size_t)(16 * sI + 8 * hh) * 256 + nb + nt * 32 + r;
            u32x4 w; w.x = cvtpk(u0[0], u0[256]); w.y = cvtpk(u0[512], u0[768]); w.z = cvtpk(u0[1024], u0[1280]); w.w = cvtpk(u0[1536], u0[1792]);
            Bf[nt][sI] = __builtin_bit_cast(bf16x8, w);
        }
    const float* b0p = (mtx < 2 ? p.in[I_RWW0] : p.in[I_RWA0]) + l * 512 + (mtx & 1) * 256 + nb;
    float bias0[4];
#pragma unroll
    for (int nt = 0; nt < 4; ++nt) bias0[nt] = b0p[nt * 32 + r];
    const int c2 = tid * 2;
    float cwa[3][2];
#pragma unroll
    for (int d = 0; d < 3; ++d) { cwa[d][0] = tid < 448 ? cw[d * 896 + c2] : 0.f; cwa[d][1] = tid < 448 ? cw[d * 896 + c2 + 1] : 0.f; }
    unsigned zr[34];
    auto zload = [&](int tile) {
        const int row0 = tile * 32;
        int seq0, L;
        if (row0 < MLAT) { seq0 = (row0 / LAT) * LAT; L = LAT; } else { seq0 = MLAT + ((row0 - MLAT) / CTX) * CTX; L = CTX; }
        const int t0 = row0 - seq0;
#pragma unroll
        for (int i = 0; i < 34; ++i) { const int t = t0 - 1 + i; zr[i] = (t >= 0 && t < L && tid < 448) ? *(const unsigned*)(Z + (size_t)(row0 - 1 + i) * 896 + c2) : 0u; }
    };
    if (bid < MROWS / 32) zload(bid);
    for (int tile = bid; tile < MROWS / 32; tile += nblk) {
        const int row0 = tile * 32;
        if (tid < 448) {
            const int arr = c2 < 256 ? 0 : (c2 < 512 ? 2 : 1), cc = c2 & 255;
#pragma unroll
            for (int i = 0; i < 32; ++i) {
                const float o0 = bflo(zr[i]) * cwa[0][0] + bflo(zr[i + 1]) * cwa[1][0] + bflo(zr[i + 2]) * cwa[2][0];
                const float o1 = bfhi(zr[i]) * cwa[0][1] + bfhi(zr[i + 1]) * cwa[1][1] + bfhi(zr[i + 2]) * cwa[2][1];
                if (c2 < 768) *(unsigned*)(RWb + arr * AS + (size_t)(row0 + i) * 256 + cc) = cvtpk(o0, o1);
                else { const int c = c2 - 768; *(unsigned*)(lowA + i * LOWLD + c) = (c < 64) ? cvtpk(ftanh(o0), ftanh(o1)) : cvtpk(o0, o1); }
            }
        }
        if (tile + nblk < MROWS / 32) zload(tile + nblk);
        __syncthreads();
        f32x16 acc[4];
#pragma unroll
        for (int nt = 0; nt < 4; ++nt)
#pragma unroll
            for (int e = 0; e < 16; ++e) acc[nt][e] = 0.f;
#pragma unroll
        for (int sI = 0; sI < 4; ++sI) {
            const bf16x8 af = *(const bf16x8*)(lowA + r * LOWLD + (mtx < 2 ? 0 : 64) + sI * 16 + hh * 8);
#pragma unroll
            for (int nt = 0; nt < 4; ++nt) acc[nt] = __builtin_amdgcn_mfma_f32_32x32x16_bf16(af, Bf[nt][sI], acc[nt], 0, 0, 0);
        }
        bf16* dst = RWb + (size_t)((mtx < 2 ? 3 : 5) + (mtx & 1)) * AS;
        const float osc = mtx < 2 ? 0.6065306597126334f : 1.0f;
#pragma unroll
        for (int nt = 0; nt < 4; ++nt)
#pragma unroll
            for (int e = 0; e < 16; ++e) {
                const int tok = (e & 3) + 8 * (e >> 2) + 4 * hh;
                const float x = bias0[nt] + acc[nt][e];
                const float o = osc * __builtin_amdgcn_rcpf(1.0f + __expf(-x));
                dst[(size_t)(row0 + tok) * 256 + nb + nt * 32 + r] = (bf16)cvtpk(o, 0.f);
            }
        __syncthreads();
    }
}

__device__ __forceinline__ void ph_attn_prep(const P& p, int l, int bid, int nblk) {
    const float2* rope = (const float2*)(p.ws + WS_ROPE);
    const int tid = tidx();
    auto item_ptr = [&](int idx) -> bf16* { const int m = idx >> 5, sl = (idx >> 3) & 3, j8 = idx & 7;
        return (bf16*)(p.ws + (sl < 2 ? WS_ZWA : WS_ZFA)) + (size_t)m * 384 + 256 + (sl & 1) * 64 + j8 * 8; };
    const int idx0 = bid * NT + tid;
    u32x4 nraw = {0u, 0u, 0u, 0u};
    if (idx0 < MROWS * 32) nraw = *(const u32x4*)item_ptr(idx0);
    for (int idx = idx0; idx < MROWS * 32; idx += nblk * NT) {
        const int m = idx >> 5, sl = (idx >> 3) & 3, j8 = idx & 7, d0 = j8 * 8;
        bf16* ptr = item_ptr(idx);
        const u32x4 raw = nraw;
        if (idx + nblk * NT < MROWS * 32) nraw = *(const u32x4*)item_ptr(idx + nblk * NT);
        float x[8] = {bflo(raw.x), bfhi(raw.x), bflo(raw.y), bfhi(raw.y), bflo(raw.z), bfhi(raw.z), bflo(raw.w), bfhi(raw.w)};
        if (sl >= 2) {
            float ss = 0.f;
#pragma unroll
            for (int j = 0; j < 8; ++j) ss += x[j] * x[j];
            ss = sum8(ss);
            const float rs = rsqrtf(ss * (1.0f / 64.0f) + 1e-6f);
            const float* g = p.in[I_FAKN] + l * 64 + d0;
#pragma unroll
            for (int j = 0; j < 8; ++j) x[j] = x[j] * rs * g[j];
        }
        if (m < MLAT) {
            const int pos = m % LAT;
            const float2* cs = rope + pos * 32 + (j8 >> 2) * 16 + (j8 & 1) * 8;
            const bool up = (j8 & 2) != 0;
#pragma unroll
            for (int j = 0; j < 8; ++j) {
                const float other = __int_as_float(__builtin_amdgcn_update_dpp(0, __float_as_int(x[j]), 0x4E, 0xF, 0xF, true));
                const float2 c = cs[j];
                x[j] = up ? (x[j] * c.x + other * c.y) : (x[j] * c.x - other * c.y);
            }
        }
        u32x4 o; o.x = cvtpk(x[0], x[1]); o.y = cvtpk(x[2], x[3]); o.z = cvtpk(x[4], x[5]); o.w = cvtpk(x[6], x[7]);
        *(u32x4*)ptr = o;
    }
}

constexpr int TC = 32;
typedef float f32x2 __attribute__((ext_vector_type(2)));
__device__ __forceinline__ float sum16(float x) {
    x += __int_as_float(__builtin_amdgcn_update_dpp(0, __float_as_int(x), 0xB1, 0xF, 0xF, true));
    x += __int_as_float(__builtin_amdgcn_update_dpp(0, __float_as_int(x), 0x4E, 0xF, 0xF, true));
    x += __int_as_float(__builtin_amdgcn_update_dpp(0, __float_as_int(x), 0x141, 0xF, 0xF, true));
    x += __int_as_float(__builtin_amdgcn_update_dpp(0, __float_as_int(x), 0x140, 0xF, 0xF, true));
    return x;
}
constexpr int SCAN_STEP_F = 320 + 64;
constexpr int SCAN_BUF_F = TC * SCAN_STEP_F;
__device__ __forceinline__ void rw_scan_chain(const P& p, int l, int item, unsigned char* smem) {
    float* bufs = (float*)smem; float* sys = bufs + 2 * SCAN_BUF_F;
    const int tid = tidx(), lane = tid & 63, wave = tid >> 6;
    const int chain = item >> 1, half = item & 1;
    const bf16* RWb = (const bf16*)(p.ws + WS_RW); const size_t AS = RW_STRIDE / 2;
    const int dir = chain & 1, h = (chain >> 1) & 3, b = chain >> 3;
    bf16* Y = (bf16*)(p.ws + (dir == 0 ? WS_YF : WS_YB));
    const int NCH = (CTX + LAT) / TC;
    auto tok_row = [&](int g) -> int {
        if (g < CTX) { int t = dir == 0 ? g : (CTX - 1 - g); return row_ctx(b, t); }
        int t = dir == 0 ? (g - CTX) : (LAT - 1 - (g - CTX)); return row_lat(b, t);
    };
    const bool producer = wave >= 4;
    const float kkw = p.in[I_RWKK][l * 256 + h * 64 + lane], kaw = p.in[I_RWKA][l * 256 + h * 64 + lane];
    auto stage = [&](int c) {
        float* buf = bufs + (c & 1) * SCAN_BUF_F;
        const int pw = wave - 4;
        bf16 gr[8], gv[8], gk[8], ge[8], ga[8];
#pragma unroll
        for (int i = 0; i < 8; ++i) {
            size_t o = (size_t)tok_row(c * TC + i * 4 + pw) * 256 + h * 64 + lane;
            gr[i] = RWb[0 * AS + o]; gv[i] = RWb[1 * AS + o]; gk[i] = RWb[2 * AS + o]; ge[i] = RWb[(3 + dir) * AS + o]; ga[i] = RWb[(5 + dir) * AS + o];
        }
#pragma unroll
        for (int i = 0; i < 8; ++i) {
            const int s = i * 4 + pw;
            float rv = bf2f(gr[i]), vv = bf2f(gv[i]), kv = bf2f(gk[i]), e = bf2f(ge[i]), a = bf2f(ga[i]);
            float kq = kv * kkw;
            const int q16 = __float_as_int(sum16(kq * kq));
            const float n2 = (__int_as_float(__builtin_amdgcn_readlane(q16, 0)) + __int_as_float(__builtin_amdgcn_readlane(q16, 16))) +
                             (__int_as_float(__builtin_amdgcn_readlane(q16, 32)) + __int_as_float(__builtin_amdgcn_readlane(q16, 48)));
            float kk = kq / fmaxf(sqrtf(n2), 1e-12f);
            float* d = buf + s * SCAN_STEP_F + (lane >> 2) * 20 + (lane & 3);
            d[0] = -kk; d[4] = __expf(-e); d[8] = kk * a; d[12] = kv * (1.0f + (a - 1.0f) * kaw); d[16] = rv;
            buf[s * SCAN_STEP_F + 320 + lane] = vv;
        }
    };
    auto ystore = [&](int c) {
        const float* sy = sys + (c & 1) * (TC * 32);
        const int pw = wave - 4;
#pragma unroll
        for (int i = 0; i < 4; ++i) { const int s = i * 8 + pw * 2 + (lane >> 5); Y[(size_t)tok_row(c * TC + s) * 256 + h * 64 + half * 32 + (lane & 31)] = f2bf(sy[s * 32 + (lane & 31)]); }
    };
    const int rp = tid >> 4, part = tid & 15;
    f32x2 Sa0 = (f32x2){0.f, 0.f}, Sa1 = Sa0, Sb0 = Sa0, Sb1 = Sa0;
    __syncthreads();
    if (producer) stage(0);
    __syncthreads();
    for (int c = 0; c < NCH; ++c) {
        if (producer) {
            if (c > 0) ystore(c - 1);
            if (c + 1 < NCH) stage(c + 1);
        } else {
            const float* buf = bufs + (c & 1) * SCAN_BUF_F; float* sy = sys + (c & 1) * (TC * 32);
            const float* bp0 = buf + part * 20; const float* vp0 = buf + 320 + half * 32 + 2 * rp;
            f32x4 k4 = *(const f32x4*)(bp0), w4 = *(const f32x4*)(bp0 + 4), b4 = *(const f32x4*)(bp0 + 8), d4 = *(const f32x4*)(bp0 + 12), r4 = *(const f32x4*)(bp0 + 16);
            f32x2 vv = *(const f32x2*)(vp0);
#pragma unroll
            for (int s16 = 0; s16 < TC / 16; ++s16) {
                float ykeepa = 0.f, ykeepb = 0.f;
#pragma unroll
                for (int s1 = 0; s1 < 16; ++s1) {
                    const int s = s16 * 16 + s1;
                    const int sn = (s + 1 < TC) ? s + 1 : s;
                    const float* bn = bp0 + sn * SCAN_STEP_F;
                    const f32x4 nk4 = *(const f32x4*)(bn), nw4 = *(const f32x4*)(bn + 4), nb4 = *(const f32x4*)(bn + 8), nd4 = *(const f32x4*)(bn + 12), nr4 = *(const f32x4*)(bn + 16);
                    const f32x2 nvv = *(const f32x2*)(vp0 + sn * SCAN_STEP_F);
                    const f32x2 kl = (f32x2){k4.x, k4.y}, kh = (f32x2){k4.z, k4.w};
                    const f32x2 pa = Sa0 * kl + Sa1 * kh, pb = Sb0 * kl + Sb1 * kh;
                    const float saa = sum16(pa.x + pa.y), sab = sum16(pb.x + pb.y);
                    const f32x2 wl = (f32x2){w4.x, w4.y}, wh = (f32x2){w4.z, w4.w}, bl = (f32x2){b4.x, b4.y}, bh = (f32x2){b4.z, b4.w}, dl = (f32x2){d4.x, d4.y}, dh = (f32x2){d4.z, d4.w};
                    const f32x2 sa2 = (f32x2){saa, saa}, sb2 = (f32x2){sab, sab}, va2 = (f32x2){vv.x, vv.x}, vb2 = (f32x2){vv.y, vv.y};
                    Sa0 = Sa0 * wl + (sa2 * bl + va2 * dl); Sa1 = Sa1 * wh + (sa2 * bh + va2 * dh);
                    Sb0 = Sb0 * wl + (sb2 * bl + vb2 * dl); Sb1 = Sb1 * wh + (sb2 * bh + vb2 * dh);
                    const f32x2 rl = (f32x2){r4.x, r4.y}, rh = (f32x2){r4.z, r4.w};
                    const f32x2 qa = Sa0 * rl + Sa1 * rh, qb = Sb0 * rl + Sb1 * rh;
                    const float ya = sum16(qa.x + qa.y), yb = sum16(qb.x + qb.y);
                    ykeepa = (part == s1) ? ya : ykeepa; ykeepb = (part == s1) ? yb : ykeepb;
                    k4 = nk4; w4 = nw4; b4 = nb4; d4 = nd4; r4 = nr4; vv = nvv;
                }
                *(f32x2*)(sy + (s16 * 16 + part) * 32 + 2 * rp) = (f32x2){ykeepa, ykeepb};
            }
        }
        __syncthreads();
    }
    if (producer) ystore(NCH - 1);
    __syncthreads();
}

typedef float f32x4v __attribute__((ext_vector_type(4)));
constexpr int CK_NRP = 72, CK_ZVP = 40, CK_WP = 24, CK_TP = 24, CK_AKP = 40, CK_SBP = 72, CK_BHP = 40;
constexpr int CK_NR = 0;
constexpr int CK_BK = CK_NR + 2 * 32 * CK_NRP * 2;
constexpr int CK_BH = CK_BK + 32 * CK_NRP * 2;
constexpr int CK_ZV = CK_BH + 2 * 64 * CK_BHP * 2;
constexpr int CK_WB = CK_ZV + 2 * 64 * CK_ZVP * 2;
constexpr int CK_TT = CK_WB + 64 * CK_WP * 2;
constexpr int CK_BKT = CK_TT + 2 * 16 * CK_TP * 2;
constexpr int CK_AK = CK_BKT + 2 * 16 * CK_TP * 2;
constexpr int CK_SB = CK_AK + 2 * 16 * CK_AKP * 2;
constexpr int CK_AM = CK_SB + 64 * CK_SBP * 2;
constexpr int CK_P15 = CK_AM + 16 * 16 * 4;
constexpr int CK_SY = CK_P15 + 2 * 64 * 4;
constexpr int CK_PM = CK_SY + 2 * 16 * 64 * 4;
constexpr int CK_END = CK_PM + 17 * 64 * 4;
static_assert(CK_END <= LDS_BYTES - 64, "chunked scan LDS");
__device__ __forceinline__ void rw_scan_chunked(const P& p, int l, int chain, unsigned char* smem) {
    const int tid = tidx(), lane = tid & 63, wave = __builtin_amdgcn_readfirstlane(tid >> 6), lr = lane & 15, lg = lane >> 4;
    const bf16* RWb = (const bf16*)(p.ws + WS_RW); const size_t AS = RW_STRIDE / 2;
    const int dir = chain & 1, h = (chain >> 1) & 3, b = chain >> 3;
    bf16* Yout = (bf16*)(p.ws + (dir == 0 ? WS_YF : WS_YB));
    constexpr int CC = 16, NCH = (CTX + LAT) / CC;
    auto lowrow = [&](int c) -> int {
        const int g0 = c * CC;
        if (g0 < CTX) return row_ctx(b, dir == 0 ? g0 : (CTX - CC - g0));
        return row_lat(b, dir == 0 ? (g0 - CTX) : (LAT - CC - (g0 - CTX)));
    };
    bf16* NR = (bf16*)(smem + CK_NR); bf16* BK = (bf16*)(smem + CK_BK); bf16* BH = (bf16*)(smem + CK_BH); bf16* ZV = (bf16*)(smem + CK_ZV);
    bf16* WB = (bf16*)(smem + CK_WB); bf16* TT = (bf16*)(smem + CK_TT); bf16* BKT = (bf16*)(smem + CK_BKT); bf16* AK = (bf16*)(smem + CK_AK);
    bf16* SB = (bf16*)(smem + CK_SB); float* AMT = (float*)(smem + CK_AM); float* P15 = (float*)(smem + CK_P15);
    float* SY = (float*)(smem + CK_SY);
    const bool isY = wave >= 4; const int wx = wave & 3;
    const float kkw = p.in[I_RWKK][l * 256 + h * 64 + lane], kaw = p.in[I_RWKA][l * 256 + h * 64 + lane];
    const bf16x8 zero8 = {0, 0, 0, 0, 0, 0, 0, 0};
    for (int i = tid; i < 64 * CK_SBP / 2; i += NT) ((unsigned*)SB)[i] = 0u;
    for (int i = tid; i < 2 * 64 * CK_ZVP / 2; i += NT) ((unsigned*)ZV)[i] = 0u;
    f32x4v Sacc[4];
#pragma unroll
    for (int n = 0; n < 4; ++n) Sacc[n] = (f32x4v){0.f, 0.f, 0.f, 0.f};
    struct Raw { u32x2 qr, qv, qk, qa; };
    Raw rawA, rawB;
    const int pst = 4 * (wave & 3) + (lane >> 4), pj = dir ? 15 - pst : pst, k0 = 4 * (lane & 15);
    float kkw4[4], kaw4[4];
#pragma unroll
    for (int i = 0; i < 4; ++i) { kkw4[i] = p.in[I_RWKK][l * 256 + h * 64 + k0 + i]; kaw4[i] = p.in[I_RWKA][l * 256 + h * 64 + k0 + i]; }
    float* PM = (float*)(smem + CK_PM);
    bf16 ge[16];
    auto eload = [&](int c) {
        const bf16* ep = RWb + (3 + dir) * AS + (size_t)lowrow(c) * 256 + h * 64 + lane;
#pragma unroll
        for (int j = 0; j < 16; ++j) ge[j] = ep[j * 256];
    };
    auto etable = [&]() {
        float pm = 0.f;
#pragma unroll
        for (int j = 0; j < 16; ++j) { pm += bf2f(ge[j]); PM[(j + 1) * 64 + lane] = pm; }
    };
    auto yload = [&](int c, Raw& R) {
        const size_t o = (size_t)(lowrow(c) + pj) * 256 + h * 64 + k0;
        R.qr = *(const u32x2*)(RWb + 0 * AS + o); R.qv = *(const u32x2*)(RWb + 1 * AS + o); R.qk = *(const u32x2*)(RWb + 2 * AS + o); R.qa = *(const u32x2*)(RWb + (5 + dir) * AS + o);
    };
    if (wave == 7) { PM[lane] = 0.f; eload(0); etable(); eload(1); }
    if (!isY) { yload(0, rawA); yload(1, rawB); }
    __syncthreads();
    auto period = [&](const int pp, Raw& R) {
        const int cb = pp & 1, nb = (pp + 1) & 1;
        const bool prep = (pp + 1 < NCH), xwork = !isY && (pp >= 0);
        if (prep && !isY) {
            const float* pmw = PM + k0;
            const f32x4v c15 = *(const f32x4v*)(pmw + 16 * 64), s0 = *(const f32x4v*)(pmw + pj * 64), s1 = *(const f32x4v*)(pmw + (pj + 1) * 64);
            const float rv[4] = {bflo(R.qr.x), bfhi(R.qr.x), bflo(R.qr.y), bfhi(R.qr.y)}, vv[4] = {bflo(R.qv.x), bfhi(R.qv.x), bflo(R.qv.y), bfhi(R.qv.y)};
            const float kv[4] = {bflo(R.qk.x), bfhi(R.qk.x), bflo(R.qk.y), bfhi(R.qk.y)}, av[4] = {bflo(R.qa.x), bfhi(R.qa.x), bflo(R.qa.y), bfhi(R.qa.y)};
            float kq[4], n2p = 0.f;
#pragma unroll
            for (int i = 0; i < 4; ++i) { kq[i] = kv[i] * kkw4[i]; n2p += kq[i] * kq[i]; }
            const float rs = __builtin_amdgcn_rsqf(fmaxf(sum16(n2p), 1e-24f));
            float nr0[4], nr1[4], bk0[4], bk1[4], bh[4], kh[4];
#pragma unroll
            for (int i = 0; i < 4; ++i) {
                const float kk = kq[i] * rs, bbv = kk * av[i], kdv = kv[i] * (1.0f + (av[i] - 1.0f) * kaw4[i]);
                const float et = s1[i] - s0[i], cst = dir ? c15[i] - s0[i] : s1[i];
                const float Pt = __expf(-cst), Pm1 = __expf(et - cst), Pinv = __expf(cst), Ph = __expf(cst - c15[i]);
                nr0[i] = -kk * Pm1; nr1[i] = rv[i] * Pt; bk0[i] = bbv * Pinv; bk1[i] = kdv * Pinv; bh[i] = bbv * Ph; kh[i] = kdv * Ph;
            }
            { u32x2 w; w.x = cvtpk(nr0[0], nr0[1]); w.y = cvtpk(nr0[2], nr0[3]); *(u32x2*)(NR + (nb * 32 + pst) * CK_NRP + k0) = w; }
            { u32x2 w; w.x = cvtpk(nr1[0], nr1[1]); w.y = cvtpk(nr1[2], nr1[3]); *(u32x2*)(NR + (nb * 32 + 16 + pst) * CK_NRP + k0) = w; }
            { u32x2 w; w.x = cvtpk(bk0[0], bk0[1]); w.y = cvtpk(bk0[2], bk0[3]); *(u32x2*)(BK + pst * CK_NRP + k0) = w; }
            { u32x2 w; w.x = cvtpk(bk1[0], bk1[1]); w.y = cvtpk(bk1[2], bk1[3]); *(u32x2*)(BK + (16 + pst) * CK_NRP + k0) = w; }
#pragma unroll
            for (int i = 0; i < 4; ++i) {
                BH[(nb * 64 + k0 + i) * CK_BHP + pst] = cvt1(bh[i]); BH[(nb * 64 + k0 + i) * CK_BHP + 16 + pst] = cvt1(kh[i]);
                ZV[(nb * 64 + k0 + i) * CK_ZVP + 16 + pst] = cvt1(vv[i]);
            }
            if (wave == 0 && lane < 16) { f32x4v e;
#pragma unroll
                for (int i = 0; i < 4; ++i) e[i] = __expf(-c15[i]);
                *(f32x4v*)(P15 + nb * 64 + k0) = e; }
        }
        if (isY && pp >= 1) {
            const float* sy = SY + ((pp - 1) & 1) * 1024;
#pragma unroll
            for (int i = 0; i < 4; ++i) { const int idx = (tid - 256) + 256 * i, t = idx >> 6, v = idx & 63; Yout[(size_t)(lowrow(pp - 1) + (dir ? 15 - t : t)) * 256 + h * 64 + v] = cvt1(sy[t * 64 + v]); }
        }
        __syncthreads();
        if (!isY && pp + 3 < NCH) yload(pp + 3, R);
        if (isY) {
            if (prep) {
                if (wave == 7 && pp + 2 < NCH) { etable(); if (pp + 3 < NCH) eload(pp + 3); }
                const int mi = wx >> 1, ni = wx & 1;
                f32x4v acc = (f32x4v){0.f, 0.f, 0.f, 0.f};
#pragma unroll
                for (int ks = 0; ks < 2; ++ks)
                    acc = __builtin_amdgcn_mfma_f32_16x16x32_bf16(*(const bf16x8*)(BK + (16 * mi + lr) * CK_NRP + 32 * ks + 8 * lg),
                                                                  *(const bf16x8*)(NR + (nb * 32 + 16 * ni + lr) * CK_NRP + 32 * ks + 8 * lg), acc, 0, 0, 0);
                f32x4v o;
#pragma unroll
                for (int rg = 0; rg < 4; ++rg) { const int i = 4 * lg + rg; o[rg] = (ni == 0 ? (i < lr) : (i <= lr)) ? acc[rg] : 0.f; }
                if (wave != 4) {
                    bf16* dst = (ni == 0) ? (BKT + (nb * 16 + lr) * CK_TP + 4 * lg) : (AK + (nb * 16 + lr) * CK_AKP + 16 * mi + 4 * lg);
                    u32x2 w; w.x = cvtpk(o[0], o[1]); w.y = cvtpk(o[2], o[3]);
                    *(u32x2*)dst = w;
                } else {
                    *(f32x4v*)(AMT + lr * 16 + 4 * lg) = o;
                    asm volatile("s_waitcnt lgkmcnt(0)" ::: "memory");
                    const int r = lane >> 2, cq = lane & 3;
                    f32x4v arow[16];
#pragma unroll
                    for (int t = 0; t < 16; ++t) arow[t] = *(const f32x4v*)(AMT + t * 16 + 4 * cq);
                    float Tq[4];
#pragma unroll
                    for (int j = 0; j < 4; ++j) Tq[j] = (r == 4 * cq + j) ? 1.0f : 0.0f;
                    int cqv = cq; asm volatile("" : "+v"(cqv));
#pragma unroll
                    for (int t = 1; t < 16; ++t) {
                        float part = Tq[0] * arow[t][0] + Tq[1] * arow[t][1] + Tq[2] * arow[t][2] + Tq[3] * arow[t][3];
                        part += __int_as_float(__builtin_amdgcn_update_dpp(0, __float_as_int(part), 0xB1, 0xF, 0xF, true));
                        part += __int_as_float(__builtin_amdgcn_update_dpp(0, __float_as_int(part), 0x4E, 0xF, 0xF, true));
                        Tq[t & 3] = (cqv == (t >> 2)) ? Tq[t & 3] + part : Tq[t & 3];
                    }
#pragma unroll
                    for (int j = 0; j < 4; ++j) TT[(nb * 16 + 4 * cq + j) * CK_TP + r] = (bf16)cvtpk(Tq[j], 0.f);
                }
            }
        } else if (xwork) {
            {
                f32x4v accN = (f32x4v){0.f, 0.f, 0.f, 0.f}, accR = accN;
#pragma unroll
                for (int ks = 0; ks < 2; ++ks) {
                    const bf16x8 a = *(const bf16x8*)(SB + (16 * wx + lr) * CK_SBP + 32 * ks + 8 * lg);
                    const bf16x8 bN = *(const bf16x8*)(NR + (cb * 32 + lr) * CK_NRP + 32 * ks + 8 * lg);
                    const bf16x8 bR = *(const bf16x8*)(NR + (cb * 32 + 16 + lr) * CK_NRP + 32 * ks + 8 * lg);
                    accN = __builtin_amdgcn_mfma_f32_16x16x32_bf16(a, bN, accN, 0, 0, 0);
                    accR = __builtin_amdgcn_mfma_f32_16x16x32_bf16(a, bR, accR, 0, 0, 0);
                }
                {
                    const bf16x8 a = (lg < 2) ? *(const bf16x8*)(ZV + (cb * 64 + 16 * wx + lr) * CK_ZVP + 16 + 8 * lg) : zero8;
                    const bf16x8 bq = (lg < 2) ? *(const bf16x8*)(BKT + (cb * 16 + lr) * CK_TP + 8 * lg) : zero8;
                    accN = __builtin_amdgcn_mfma_f32_16x16x32_bf16(a, bq, accN, 0, 0, 0);
                }
#pragma unroll
                for (int rg = 0; rg < 4; ++rg) WB[(16 * wx + 4 * lg + rg) * CK_WP + lr] = cvt1(accN[rg]);
                asm volatile("s_waitcnt lgkmcnt(0)" ::: "memory");
                const bf16x8 aw = (lg < 2) ? *(const bf16x8*)(WB + (16 * wx + lr) * CK_WP + 8 * lg) : zero8;
                const bf16x8 bt = (lg < 2) ? *(const bf16x8*)(TT + (cb * 16 + lr) * CK_TP + 8 * lg) : zero8;
                const f32x4v accZ = __builtin_amdgcn_mfma_f32_16x16x32_bf16(aw, bt, (f32x4v){0.f, 0.f, 0.f, 0.f}, 0, 0, 0);
#pragma unroll
                for (int rg = 0; rg < 4; ++rg) ZV[(cb * 64 + 16 * wx + 4 * lg + rg) * CK_ZVP + lr] = cvt1(accZ[rg]);
                asm volatile("s_waitcnt lgkmcnt(0)" ::: "memory");
                const bf16x8 a = *(const bf16x8*)(ZV + (cb * 64 + 16 * wx + lr) * CK_ZVP + 8 * lg);
                const f32x4v accY = __builtin_amdgcn_mfma_f32_16x16x32_bf16(a, *(const bf16x8*)(AK + (cb * 16 + lr) * CK_AKP + 8 * lg), accR, 0, 0, 0);
                *(f32x4v*)(SY + cb * 1024 + lr * 64 + 16 * wx + 4 * lg) = accY;
#pragma unroll
                for (int n = 0; n < 4; ++n) {
                    const float pc = P15[cb * 64 + 16 * n + lr];
                    Sacc[n] = Sacc[n] * pc;
                    Sacc[n] = __builtin_amdgcn_mfma_f32_16x16x32_bf16(a, *(const bf16x8*)(BH + (cb * 64 + 16 * n + lr) * CK_BHP + 8 * lg), Sacc[n], 0, 0, 0);
#pragma unroll
                    for (int rg = 0; rg < 4; ++rg) SB[(16 * wx + 4 * lg + rg) * CK_SBP + 16 * n + lr] = cvt1(Sacc[n][rg]);
                }
            }
        }
        __syncthreads();
    };
    for (int pp = -1; pp < NCH; pp += 2) { period(pp, rawA); if (pp + 1 < NCH) period(pp + 1, rawB); }
    if (!isY) {
        const float* sy = SY + ((NCH - 1) & 1) * 1024;
#pragma unroll
        for (int i = 0; i < 4; ++i) { const int idx = tid + 256 * i, t = idx >> 6, v = idx & 63; Yout[(size_t)(lowrow(NCH - 1) + (dir ? 15 - t : t)) * 256 + h * 64 + v] = (bf16)cvtpk(sy[t * 64 + v], 0.f); }
    }
    __syncthreads();
}

__device__ __forceinline__ void ph_rw_readout(const P& p, int l, int row_lo, int row_hi, int bid, int nblk) {
    const int tid = tidx();
    const bf16* RWb = (const bf16*)(p.ws + WS_RW); const size_t AS = RW_STRIDE / 2;
    const bf16* YF = (const bf16*)(p.ws + WS_YF); const bf16* YB = (const bf16*)(p.ws + WS_YB);
    const bf16* G = (const bf16*)(p.ws + WS_GATES); bf16* MIX = (bf16*)(p.ws + WS_MIX);
    const int c0 = (tid & 31) * 8;
    float kaw[8], rk[8], lg[8], lb[8];
#pragma unroll
    for (int j = 0; j < 8; ++j) { kaw[j] = p.in[I_RWKA][l * 256 + c0 + j]; rk[j] = p.in[I_RWRK][l * 256 + c0 + j]; lg[j] = p.in[I_RWLNG][l * 256 + c0 + j]; lb[j] = p.in[I_RWLNB][l * 256 + c0 + j]; }
    for (int idx = row_lo * 32 + bid * NT + tid; idx < row_hi * 32; idx += nblk * NT) {
        const int m = idx >> 5;
        const size_t o = (size_t)m * 256 + c0;
        u32x4 outw;
#if EN_B
        const u32x4 yf = *(const u32x4*)(YF + o), yb = *(const u32x4*)(YB + o), rr = *(const u32x4*)(RWb + 0 * AS + o), vv = *(const u32x4*)(RWb + 1 * AS + o),
                    kk = *(const u32x4*)(RWb + 2 * AS + o), af = *(const u32x4*)(RWb + 5 * AS + o), ab = *(const u32x4*)(RWb + 6 * AS + o), gg = *(const u32x4*)(G + (size_t)m * 1024 + 256 + c0);
        float y[8], rv[8], v8[8], kv[8], a8[8], g8[8];
#pragma unroll
        for (int q = 0; q < 4; ++q) {
            y[2 * q] = bflo(yf[q]) + bflo(yb[q]); y[2 * q + 1] = bfhi(yf[q]) + bfhi(yb[q]);
            rv[2 * q] = bflo(rr[q]); rv[2 * q + 1] = bfhi(rr[q]); v8[2 * q] = bflo(vv[q]); v8[2 * q + 1] = bfhi(vv[q]);
            kv[2 * q] = bflo(kk[q]); kv[2 * q + 1] = bfhi(kk[q]); a8[2 * q] = bflo(af[q]) + bflo(ab[q]); a8[2 * q + 1] = bfhi(af[q]) + bfhi(ab[q]);
            g8[2 * q] = bflo(gg[q]); g8[2 * q + 1] = bfhi(gg[q]);
        }
        float s1 = 0.f, bn = 0.f;
#pragma unroll
        for (int j = 0; j < 8; ++j) { s1 += y[j]; bn += rv[j] * kv[j] * (2.0f + (a8[j] - 2.0f) * kaw[j]) * rk[j]; }
        s1 = sum8(s1); bn = sum8(bn);
        const float mu = s1 * (1.0f / 64.0f);
        float s2 = 0.f;
#pragma unroll
        for (int j = 0; j < 8; ++j) { y[j] -= mu; s2 += y[j] * y[j]; }
        s2 = sum8(s2);
        const float rs = rsqrtf(s2 * (1.0f / 64.0f) + 64e-5f);
        float ov[8];
#pragma unroll
        for (int j = 0; j < 8; ++j) ov[j] = (y[j] * rs * lg[j] + lb[j] + bn * v8[j]) * siluf(g8[j]);
        outw.x = cvtpk(ov[0], ov[1]); outw.y = cvtpk(ov[2], ov[3]); outw.z = cvtpk(ov[4], ov[5]); outw.w = cvtpk(ov[6], ov[7]);
#else
        outw.x = 0; outw.y = 0; outw.z = 0; outw.w = 0;
#endif
        *(u32x4*)(MIX + (size_t)m * 1024 + 256 + c0) = outw;
    }
}

constexpr int HPT = 72;
__device__ __forceinline__ void ph_hy_prep(const P& p, int l, unsigned char* smem, int bid, int nblk) {
    constexpr int TP = 66;
    bf16* tiles = (bf16*)smem;
    const int tid = tidx();
    const bf16* Z = (const bf16*)(p.ws + WS_ZHY); const bf16* G = (const bf16*)(p.ws + WS_GATES); bf16* HT = (bf16*)(p.ws + WS_HMIX);
    const float* cw = p.in[I_HYCONV] + (size_t)l * 3 * 768;
    const int rr = tid >> 3, ch = tid & 7;
    const int nst = (nblk >= 16) ? (nblk >> 4) : 1;
    const int ct = bid & 15, kind = ct >> 2, c0 = (ct & 3) * 64;
    float w0[8], w1[8], w2[8];
#pragma unroll
    for (int j = 0; j < 8; ++j) { const int col = (kind < 3 ? kind : 0) * 256 + c0 + ch * 8 + j; w0[j] = cw[col]; w1[j] = cw[768 + col]; w2[j] = cw[1536 + col]; }
    u32x4 rc0 = {0u, 0u, 0u, 0u}, rc1 = rc0, rc2 = rc0;
    auto seq = [&](int st, int& b, int& t0, int& L, int& row0, size_t& obase) {
        if (st < 512) { b = st >> 6; t0 = (st & 63) * 64; L = LAT; row0 = row_lat(b, 0); obase = (size_t)b * 4 * 256 * LAT; }
        else { const int s2 = st - 512; b = s2 >> 2; t0 = (s2 & 3) * 64; L = CTX; row0 = row_ctx(b, 0); obase = HYT_CTX_OFF + (size_t)b * 4 * 256 * CTX; }
    };
    auto tload = [&](int st) {
        int b, t0, L, row0; size_t obase; seq(st, b, t0, L, row0, obase);
        const int t = t0 + rr;
        rc0 = (u32x4){0u, 0u, 0u, 0u}; rc2 = rc0;
        if (kind < 3) {
            const bf16* zp = Z + (size_t)(row0 + t) * 768 + kind * 256 + c0 + ch * 8;
            rc1 = *(const u32x4*)zp;
            if (t > 0) rc0 = *(const u32x4*)(zp - 768);
            if (t < L - 1) rc2 = *(const u32x4*)(zp + 768);
        } else rc1 = *(const u32x4*)(G + (size_t)(row0 + t) * 1024 + c0 + ch * 8);
    };
    const int st0 = bid >> 4;
    if (bid >= nst * 16) return;
    if (st0 < 544) tload(st0);
    int it = 0;
    for (int st = st0; st < 544; st += nst, ++it) {
        int b, t0, L, row0; size_t obase; seq(st, b, t0, L, row0, obase);
        float o[8];
        if (kind < 3) {
#pragma unroll
            for (int q = 0; q < 4; ++q) {
                o[2 * q] = bflo(rc0[q]) * w0[2 * q] + bflo(rc1[q]) * w1[2 * q] + bflo(rc2[q]) * w2[2 * q];
                o[2 * q + 1] = bfhi(rc0[q]) * w0[2 * q + 1] + bfhi(rc1[q]) * w1[2 * q + 1] + bfhi(rc2[q]) * w2[2 * q + 1];
            }
        } else {
#pragma unroll
            for (int q = 0; q < 4; ++q) { o[2 * q] = siluf(bflo(rc1[q])); o[2 * q + 1] = siluf(bfhi(rc1[q])); }
        }
        if (st + nst < 544) tload(st + nst);
        bf16* tile = tiles + (it & 1) * (64 * TP);
        unsigned* trow = (unsigned*)(tile + rr * TP + ch * 8);
        trow[0] = cvtpk(o[0], o[1]); trow[1] = cvtpk(o[2], o[3]); trow[2] = cvtpk(o[4], o[5]); trow[3] = cvtpk(o[6], o[7]);
        __syncthreads();
        const bf16* tc = tile + (ch * 8) * TP + rr;
        u32x4 w;
        w.x = (unsigned)tc[0] | ((unsigned)tc[TP] << 16); w.y = (unsigned)tc[2 * TP] | ((unsigned)tc[3 * TP] << 16);
        w.z = (unsigned)tc[4 * TP] | ((unsigned)tc[5 * TP] << 16); w.w = (unsigned)tc[6 * TP] | ((unsigned)tc[7 * TP] << 16);
        *(u32x4*)(HT + obase + ((size_t)kind * 256 + c0 + rr) * L + t0 + ch * 8) = w;
    }
    __syncthreads();
}

__device__ __forceinline__ void hyena_task(const P& p, int l, int task, unsigned char* smem) {
    float2* X = (float2*)smem; float2* TW = X + XLEN;
    const int tid = tidx();
    bf16* HT = (bf16*)(p.ws + WS_HMIX);
    const float* bias = p.in[I_HYBIAS] + l * 512;
    const int c = task >> 2, pr = task & 3; const int b0 = 2 * pr, b1 = 2 * pr + 1;
    const float bs0 = bias[c], bs1 = bias[256 + c];
    fft_load_tw(TW, (const float2*)(p.ws + WS_TW));
    const int t0 = tid * 8;
    bf16* base0 = HT + ((size_t)(b0 * 4) * 256 + c) * LAT + t0; bf16* base1 = HT + ((size_t)(b1 * 4) * 256 + c) * LAT + t0;
    const size_t KS = (size_t)256 * LAT;
    const u32x4 v0 = *(const u32x4*)(base0), v1 = *(const u32x4*)(base1);
    float va[8], vb[8];
#pragma unroll
    for (int q = 0; q < 4; ++q) { va[2 * q] = bflo(v0[q]); va[2 * q + 1] = bfhi(v0[q]); vb[2 * q] = bflo(v1[q]); vb[2 * q + 1] = bfhi(v1[q]); }
    const int xb = t0 + (tid >> 2);
    const int zb = PADI(4096 + t0);
#pragma unroll
    for (int j = 0; j < 8; ++j) { X[xb + j] = make_float2(va[j], vb[j]); X[zb + j] = make_float2(0.f, 0.f); }
    __syncthreads();
    float ya[8], yb[8];
    const u32x2* KH0 = (const u32x2*)((const unsigned*)(p.ws + WS_KHAT + (size_t)(l & 1) * KHAT_COPY) + (size_t)c * NFFT);
    const u32x2* KH1 = (const u32x2*)((const unsigned*)(p.ws + WS_KHAT + (size_t)(l & 1) * KHAT_COPY) + (size_t)(256 + c) * NFFT);
    u32x2 kh[8];
#pragma unroll
    for (int i = 0; i < 8; ++i) kh[i] = KH0[tid + NT * i];
    u32x4 xa0 = *(const u32x4*)(base0 + KS), xa1 = *(const u32x4*)(base1 + KS);
    u32x4 g0 = {0u, 0u, 0u, 0u}, g1 = {0u, 0u, 0u, 0u};
#pragma unroll
    for (int o = 0; o < 2; ++o) {
        fft_fwd_hi(X, TW);
#pragma unroll
        for (int i = 0; i < 8; ++i) {
            int pi = tid + NT * i; float2 a = X[PADI(2 * pi)], bq = X[PADI(2 * pi + 1)];
            const u32x2 kk = kh[i];
            float2 u = make_float2(a.x + bq.x, a.y + bq.y), v = make_float2(a.x - bq.x, a.y - bq.y);
            u = cmul(u, make_float2(bflo(kk.x), bfhi(kk.x))); v = cmul(v, make_float2(bflo(kk.y), bfhi(kk.y)));
            X[PADI(2 * pi)] = make_float2(u.x + v.x, u.y + v.y); X[PADI(2 * pi + 1)] = make_float2(u.x - v.x, u.y - v.y);
        }
        __syncthreads();
        if (o == 0) {
#pragma unroll
            for (int i = 0; i < 8; ++i) kh[i] = KH1[tid + NT * i];
            g0 = *(const u32x4*)(base0 + 3 * KS); g1 = *(const u32x4*)(base1 + 3 * KS);
        }
        fft_inv_hi(X, TW);
        if (o == 0) {
#pragma unroll
            for (int j = 0; j < 8; ++j) {
                const float2 cvv = X[xb + j];
                const float xa = (j & 1) ? bfhi(xa0[j >> 1]) : bflo(xa0[j >> 1]), xbv = (j & 1) ? bfhi(xa1[j >> 1]) : bflo(xa1[j >> 1]);
                ya[j] = xa * (cvv.x + bs0 * va[j]); yb[j] = xbv * (cvv.y + bs0 * vb[j]);
                X[xb + j] = make_float2(ya[j], yb[j]); X[zb + j] = make_float2(0.f, 0.f);
            }
            xa0 = *(const u32x4*)(base0 + 2 * KS); xa1 = *(const u32x4*)(base1 + 2 * KS);
            __syncthreads();
        } else {
            float oa[8], ob[8];
#pragma unroll
            for (int j = 0; j < 8; ++j) {
                const float2 cvv = X[xb + j];
                const float xa = (j & 1) ? bfhi(xa0[j >> 1]) : bflo(xa0[j >> 1]), xbv = (j & 1) ? bfhi(xa1[j >> 1]) : bflo(xa1[j >> 1]);
                const float ga = (j & 1) ? bfhi(g0[j >> 1]) : bflo(g0[j >> 1]), gb = (j & 1) ? bfhi(g1[j >> 1]) : bflo(g1[j >> 1]);
                oa[j] = xa * (cvv.x + bs1 * ya[j]) * ga; ob[j] = xbv * (cvv.y + bs1 * yb[j]) * gb;
            }
            u32x4 wa, wb;
            wa.x = cvtpk(oa[0], oa[1]); wa.y = cvtpk(oa[2], oa[3]); wa.z = cvtpk(oa[4], oa[5]); wa.w = cvtpk(oa[6], oa[7]);
            wb.x = cvtpk(ob[0], ob[1]); wb.y = cvtpk(ob[2], ob[3]); wb.z = cvtpk(ob[4], ob[5]); wb.w = cvtpk(ob[6], ob[7]);
            *(u32x4*)base0 = wa; *(u32x4*)base1 = wb;
            __syncthreads();
        }
    }
}
__device__ __forceinline__ void hyena_ctx_task(const P& p, int l, int task2, unsigned char* smem) {
    const int half = tidx() >> 8, t = tidx() & 255;
    float* u = (float*)smem + half * 768; float* G = u + 256;
    const bf16* HT = (const bf16*)(p.ws + WS_HMIX) + HYT_CTX_OFF; bf16* MIX = (bf16*)(p.ws + WS_MIX);
    const float* bias = p.in[I_HYBIAS] + l * 512; const float* HC = (const float*)(p.ws + ((l & 1) ? WS_HCTX2 : WS_HCTX));
    const int task = task2 * 2 + half;
    const int b = task >> 8, c = task & 255; const size_t m = row_ctx(b, t);
    const bf16* hb0 = HT + ((size_t)(b * 4) * 256 + c) * CTX + t; const size_t KS = (size_t)256 * CTX;
    const float v = bf2f(hb0[0]), x1 = bf2f(hb0[KS]), x2 = bf2f(hb0[2 * KS]), sg = bf2f(hb0[3 * KS]);
    float cur = v, res = 0.f;
    const float* Gt = G + (255 - t);
    for (int o = 0; o < 2; ++o) {
        const float hfv = HC[((o * 2 + 0) * 256 + c) * 256 + t], hbv = HC[((o * 2 + 1) * 256 + c) * 256 + t];
        __syncthreads();
        u[t] = cur; G[255 - t] = hfv; if (t > 0) G[255 + t] = hbv;
        if (t == 0) G[511] = 0.f;
        __syncthreads();
        float acc0 = 0.f, acc1 = 0.f, acc2 = 0.f, acc3 = 0.f;
#pragma unroll 8
        for (int s = 0; s < CTX; s += 4) {
            const f32x4 uu = *(const f32x4*)(u + s);
            acc0 += uu.x * Gt[s]; acc1 += uu.y * Gt[s + 1]; acc2 += uu.z * Gt[s + 2]; acc3 += uu.w * Gt[s + 3];
        }
        const float acc = (acc0 + acc1) + (acc2 + acc3);
        float y = (o == 0 ? x1 : x2) * (acc + bias[o * 256 + c] * cur);
        cur = y; res = y;
    }
    MIX[m * 1024 + c] = f2bf(res * sg);
    __syncthreads();
}
__device__ __forceinline__ void ph_hy_out(const P& p, unsigned char* smem, int bid, int nblk) {
    bf16* tile = (bf16*)smem;
    const int tid = tidx(), rr = tid >> 3, ch = tid & 7;
    const bf16* HT = (const bf16*)(p.ws + WS_HMIX); bf16* MIX = (bf16*)(p.ws + WS_MIX);
    for (int tl = bid; tl < 2048; tl += nblk) {
        const int ct = tl & 3, tt = (tl >> 2) & 63, b = tl >> 8; const int c0 = ct * 64, t0 = tt * 64;
        const u32x4 w = *(const u32x4*)(HT + ((size_t)(b * 4) * 256 + c0 + rr) * LAT + t0 + ch * 8);
        tile[(ch * 8 + 0) * HPT + rr] = (bf16)(w.x & 0xffff); tile[(ch * 8 + 1) * HPT + rr] = (bf16)(w.x >> 16);
        tile[(ch * 8 + 2) * HPT + rr] = (bf16)(w.y & 0xffff); tile[(ch * 8 + 3) * HPT + rr] = (bf16)(w.y >> 16);
        tile[(ch * 8 + 4) * HPT + rr] = (bf16)(w.z & 0xffff); tile[(ch * 8 + 5) * HPT + rr] = (bf16)(w.z >> 16);
        tile[(ch * 8 + 6) * HPT + rr] = (bf16)(w.w & 0xffff); tile[(ch * 8 + 7) * HPT + rr] = (bf16)(w.w >> 16);
        __syncthreads();
        const u32x4 o = *(const u32x4*)(tile + rr * HPT + ch * 8);
        *(u32x4*)(MIX + (size_t)row_lat(b, t0 + rr) * 1024 + c0 + ch * 8) = o;
        __syncthreads();
    }
}

constexpr int ALD = 72;
__device__ __forceinline__ int kperm(int i) { return (i & ~12) | ((i & 8) >> 1) | ((i & 4) << 1); }
__device__ __forceinline__ void attn_task(const P& p, int l, int task, unsigned char* smem) {
    bf16* Ks = (bf16*)smem; bf16* Vs = Ks + 64 * ALD;
    const int tid = tidx(), lane = tid & 63, wave = tid >> 6, r = lane & 31, hh = lane >> 5;
    int kind, rem;
    if (task < 512) { kind = 1; rem = task; } else if (task < 1024) { kind = 0; rem = task - 512; } else if (task < 1056) { kind = 2; rem = task - 1024; } else { kind = 3; rem = task - 1056; }
    const bool win = (kind == 0 || kind == 2), qctx = kind >= 2;
    const int nqb = qctx ? 2 : 32;
    const int qb = rem % nqb, kvh = (rem / nqb) & 1, b = rem / (nqb * 2), h = kvh * 2 + (wave >> 2);
    const bf16* ZQ = (const bf16*)(p.ws + (win ? WS_ZWA : WS_ZFA));
    const bf16* VT = (const bf16*)(p.ws + (win ? WS_VTW : WS_VTF)) + (size_t)(b * 2 + kvh) * 64 * SKV;
    bf16* MIX = (bf16*)(p.ws + WS_MIX); const bf16* G = (const bf16*)(p.ws + WS_GATES);
    const int mixc = (win ? 512 : 768) + h * 64;
    const int q0 = qb * 128;
    const int qpos = q0 + (wave & 3) * 32 + r;
    const size_t qrow = qctx ? row_ctx(b, qpos) : row_lat(b, qpos);
    const bool enabled = win ? (EN_C != 0) : (EN_D != 0);
    if (!enabled) {
        for (int i = tid; i < 128 * 128; i += NT) { int rr = i >> 7, cc = i & 127; size_t rw = qctx ? row_ctx(b, q0 + rr) : row_lat(b, q0 + rr); MIX[rw * 1024 + (win ? 512 : 768) + kvh * 128 + cc] = 0; }
        return;
    }
    bf16x8 qf[4];
    {
        float qv[4][8];
#pragma unroll
        for (int s = 0; s < 4; ++s) { const u32x4 raw = *(const u32x4*)(ZQ + qrow * 384 + h * 64 + s * 16 + hh * 8);
            qv[s][0] = bflo(raw.x); qv[s][1] = bfhi(raw.x); qv[s][2] = bflo(raw.y); qv[s][3] = bfhi(raw.y); qv[s][4] = bflo(raw.z); qv[s][5] = bfhi(raw.z); qv[s][6] = bflo(raw.w); qv[s][7] = bfhi(raw.w); }
        float qs = 0.125f * 1.4426950408889634f;
        if (!win) {
            float ss = 0.f;
#pragma unroll
            for (int s = 0; s < 4; ++s)
#pragma unroll
                for (int j = 0; j < 8; ++j) ss += qv[s][j] * qv[s][j];
            ss += __shfl_xor(ss, 32);
            const float rs = rsqrtf(ss * (1.0f / 64.0f) + 1e-6f);
            const float* gq = p.in[I_FAQN] + l * 64;
#pragma unroll
            for (int s = 0; s < 4; ++s)
#pragma unroll
                for (int j = 0; j < 8; ++j) qv[s][j] *= rs * gq[s * 16 + hh * 8 + j];
        }
        if (!qctx) {
            const float2* cs = (const float2*)(p.ws + WS_ROPE) + qpos * 32 + hh * 8;
#pragma unroll
            for (int sec = 0; sec < 2; ++sec)
#pragma unroll
                for (int j = 0; j < 8; ++j) { const float2 c = cs[sec * 16 + j]; const float xa = qv[2 * sec][j], xb = qv[2 * sec + 1][j];
                    qv[2 * sec][j] = xa * c.x - xb * c.y; qv[2 * sec + 1][j] = xb * c.x + xa * c.y; }
        }
#pragma unroll
        for (int s = 0; s < 4; ++s) { u32x4 w; w.x = cvtpk(qv[s][0] * qs, qv[s][1] * qs); w.y = cvtpk(qv[s][2] * qs, qv[s][3] * qs); w.z = cvtpk(qv[s][4] * qs, qv[s][5] * qs); w.w = cvtpk(qv[s][6] * qs, qv[s][7] * qs);
            qf[s] = __builtin_bit_cast(bf16x8, w); }
    }
    f32x16 oacc[2];
#pragma unroll
    for (int e = 0; e < 16; ++e) { oacc[0][e] = 0.f; oacc[1][e] = 0.f; }
    float mrun = -1e30f, lrun = 0.f;
    int ntile, lt0 = 0;
    if (qctx) ntile = 4;
    else if (!win) ntile = 68;
    else { int lo = q0 - 128; if (lo < 0) lo = 0; int hi = q0 + 256; if (hi > LAT) hi = LAT; lt0 = lo / 64; ntile = 4 + (hi - lo) / 64; }
    bf16* Vb = Ks + 2 * 64 * ALD;
    const bool grpB = __builtin_amdgcn_readfirstlane(wave) >= 4;
    const int srw = tid >> 3, sch = tid & 7;
    auto tile_key0 = [&](int ti) -> int { const int kt = (ti < 4) ? ti : (win ? (4 + lt0 + (ti - 4)) : ti); return kt * 64; };
    u32x4 kregA, vregA, kregB, vregB;
    auto tile_load = [&](int ti, u32x4& kreg, u32x4& vreg) {
        const int key0 = tile_key0(ti);
        const size_t krow0 = (key0 < CTX) ? (size_t)row_ctx(b, key0) : (size_t)row_lat(b, key0 - CTX);
        kreg = *(const u32x4*)(ZQ + (krow0 + srw) * 384 + 256 + kvh * 64 + sch * 8);
        vreg = *(const u32x4*)(VT + (size_t)srw * SKV + key0 + sch * 8);
    };
    const int qw = q0 + (__builtin_amdgcn_readfirstlane(wave) & 3) * 32;
    bf16x8 pf[2][2], kf[2][4], vf[2][2][2];
    auto kload = [&](int ti) {
        const bf16* Kc = Ks + (ti & 1) * (64 * ALD);
#pragma unroll
        for (int sub = 0; sub < 2; ++sub)
#pragma unroll
            for (int s = 0; s < 4; ++s) kf[sub][s] = *(const bf16x8*)(Kc + (sub * 32 + kperm(r)) * ALD + s * 16 + hh * 8);
    };
    auto vload1 = [&](int vslot, int dt) {
        const bf16* Vc = Vb + vslot * (64 * ALD);
#pragma unroll
        for (int sub = 0; sub < 2; ++sub)
#pragma unroll
            for (int s2 = 0; s2 < 2; ++s2) vf[dt][sub][s2] = *(const bf16x8*)(Vc + (dt * 32 + r) * ALD + sub * 32 + s2 * 16 + hh * 8);
    };
    auto vload = [&](int vslot) { vload1(vslot, 0); vload1(vslot, 1); };
    auto pv = [&]() {
        __builtin_amdgcn_s_setprio(1);
#pragma unroll
        for (int dt = 0; dt < 2; ++dt)
#pragma unroll
            for (int sub = 0; sub < 2; ++sub)
#pragma unroll
                for (int s2 = 0; s2 < 2; ++s2) oacc[dt] = __builtin_amdgcn_mfma_f32_32x32x16_bf16(vf[dt][sub][s2], pf[sub][s2], oacc[dt], 0, 0, 0);
        __builtin_amdgcn_s_setprio(0);
    };
    auto qk_sm = [&](int ti, int vslot) {
        const int key0 = tile_key0(ti);
        f32x16 sc[2];
        __builtin_amdgcn_s_setprio(1);
#pragma unroll
        for (int sub = 0; sub < 2; ++sub) {
#pragma unroll
            for (int e = 0; e < 16; ++e) sc[sub][e] = 0.f;
#pragma unroll
            for (int s = 0; s < 4; ++s) sc[sub] = __builtin_amdgcn_mfma_f32_32x32x16_bf16(kf[sub][s], qf[s], sc[sub], 0, 0, 0);
        }
        __builtin_amdgcn_s_setprio(0);
        if (vslot >= 0) { vload1(vslot, 0); __builtin_amdgcn_sched_barrier(0); }
        if (win && key0 >= CTX && !(key0 - CTX >= qw + 31 - 128 && key0 - CTX + 63 <= qw + 128)) {
#pragma unroll
            for (int sub = 0; sub < 2; ++sub)
#pragma unroll
                for (int e = 0; e < 16; ++e) {
                    int kpos = key0 - CTX + sub * 32 + 16 * (e >> 3) + 8 * hh + (e & 7);
                    int dlt = qpos - kpos; if (dlt < 0) dlt = -dlt;
                    if (dlt > 128) sc[sub][e] = -1e30f;
                }
        }
        float mx = sc[0][0];
#pragma unroll
        for (int e = 1; e < 16; ++e) mx = fmaxf(mx, sc[0][e]);
#pragma unroll
        for (int e = 0; e < 16; ++e) mx = fmaxf(mx, sc[1][e]);
        { const unsigned um = __float_as_uint(mx); auto rr = __builtin_amdgcn_permlane32_swap(um, um, false, false); mx = fmaxf(__uint_as_float(rr[0]), __uint_as_float(rr[1])); }
        if (__any(mx > mrun + 8.0f)) {
            const float mnew = fmaxf(mrun, mx);
            const float alpha = __builtin_amdgcn_exp2f(mrun - mnew);
            mrun = mnew; lrun *= alpha;
#pragma unroll
            for (int e = 0; e < 16; ++e) { oacc[0][e] *= alpha; oacc[1][e] *= alpha; }
        }
        float ps = 0.f;
#pragma unroll
        for (int sub = 0; sub < 2; ++sub)
#pragma unroll
            for (int s2 = 0; s2 < 2; ++s2) {
                float pe[8];
#pragma unroll
                for (int jj = 0; jj < 8; ++jj) { pe[jj] = __builtin_amdgcn_exp2f(sc[sub][8 * s2 + jj] - mrun); ps += pe[jj]; }
                u32x4 w; w.x = cvtpk(pe[0], pe[1]); w.y = cvtpk(pe[2], pe[3]); w.z = cvtpk(pe[4], pe[5]); w.w = cvtpk(pe[6], pe[7]);
                pf[sub][s2] = __builtin_bit_cast(bf16x8, w);
            }
        lrun += ps;
    };
    auto tile_store = [&](int ti, int vslot, const u32x4& kreg, const u32x4& vreg) {
        *(u32x4*)(Ks + (ti & 1) * (64 * ALD) + srw * ALD + sch * 8) = kreg; *(u32x4*)(Vb + vslot * (64 * ALD) + srw * ALD + sch * 8) = vreg;
    };
    __syncthreads();
    tile_load(0, kregA, vregA);
    tile_load(1, kregB, vregB);
    tile_store(0, 0, kregA, vregA);
    __syncthreads();
    int vs0 = 0;
    for (int ti = 0; ti < ntile; ti += 2) {
        const int vs1 = vs0 == 2 ? 0 : vs0 + 1, vs2 = vs1 == 2 ? 0 : vs1 + 1;
        if (ti + 2 < ntile) tile_load(ti + 2, kregA, vregA);
        if (grpB) { if (ti > 0) { vload(vs2); __builtin_amdgcn_sched_barrier(0); pv(); } kload(ti); __builtin_amdgcn_sched_barrier(0); qk_sm(ti, -1); }
        else { kload(ti); __builtin_amdgcn_sched_barrier(0); qk_sm(ti, vs0); vload1(vs0, 1); __builtin_amdgcn_sched_barrier(0); pv(); }
        tile_store(ti + 1, vs1, kregB, vregB);
        __syncthreads();
        if (ti + 3 < ntile) tile_load(ti + 3, kregB, vregB);
        if (grpB) { vload(vs0); __builtin_amdgcn_sched_barrier(0); pv(); kload(ti + 1); __builtin_amdgcn_sched_barrier(0); qk_sm(ti + 1, -1); }
        else { kload(ti + 1); __builtin_amdgcn_sched_barrier(0); qk_sm(ti + 1, vs1); vload1(vs1, 1); __builtin_amdgcn_sched_barrier(0); pv(); }
        if (ti + 2 < ntile) tile_store(ti + 2, vs2, kregA, vregA);
        __syncthreads();
        vs0 = vs2;
    }
    if (grpB) { vload(vs0 == 0 ? 2 : vs0 - 1); pv(); }
    lrun += __shfl_xor(lrun, 32);
    if (win) lrun += __builtin_amdgcn_exp2f(p.in[I_WASINK][l * 4 + h] * 1.4426950408889634f - mrun);
    const float inv = 1.0f / lrun;
#pragma unroll
    for (int dt = 0; dt < 2; ++dt)
#pragma unroll
        for (int g = 0; g < 4; ++g) {
            int d0 = dt * 32 + 8 * g + 4 * hh;
            u32x2 gv = *(const u32x2*)(G + qrow * 1024 + mixc + d0);
            float g0 = bf2f((bf16)(gv.x & 0xffff)), g1 = bf2f((bf16)(gv.x >> 16)), g2 = bf2f((bf16)(gv.y & 0xffff)), g3 = bf2f((bf16)(gv.y >> 16));
            u32x2 w; w.x = pk2(oacc[dt][4 * g] * inv * siluf(g0), oacc[dt][4 * g + 1] * inv * siluf(g1));
            w.y = pk2(oacc[dt][4 * g + 2] * inv * siluf(g2), oacc[dt][4 * g + 3] * inv * siluf(g3));
            *(u32x2*)(MIX + qrow * 1024 + mixc + d0) = w;
        }
    __syncthreads();
}

constexpr int MIX_NATT = 1088, MIX_NHY = 1024, MIX_NHYC = 1024;
constexpr int MIX_NWC = 148, MIX_NFL = 1024;
__device__ __forceinline__ void ph_mixer(const P& p, int l, unsigned char* smem, int bid, int nblk) {
    volatile int* s_task = (volatile int*)(smem + LDS_BYTES - 16);
    if (bid < 64) {
#if EN_B
#if PROBE
        unsigned long long t0 = __builtin_amdgcn_s_memrealtime();
#endif
        rw_scan_chunked(p, l, bid, smem);
#if PROBE
        if (bid == 0 && l == 1 && tidx() == 0) ((unsigned long long*)(p.ws + WS_CTL))[256 + 1] = __builtin_amdgcn_s_memrealtime() - t0;
#endif
#endif
    }
    unsigned* ctr = (unsigned*)(p.ws + WS_CTL) + 64 * (1 + l);
    const int ntask = MIX_NATT + MIX_NHY + (l < DEPTH - 1 ? MIX_NHYC + MIX_NWC + MIX_NFL : 0);
    for (;;) {
        __syncthreads();
        if (tidx() == 0) *s_task = (int)atomicAdd(ctr, 1u);
        __syncthreads();
        const int t = __builtin_amdgcn_readfirstlane(*s_task);
        if (t >= ntask) break;
        P q = p; FENCE(q);
        if (t < MIX_NATT) attn_task(q, l, t, smem);
        else if (t < MIX_NATT + MIX_NHY) hyena_task(q, l, t - MIX_NATT, smem);
        else if (t < MIX_NATT + MIX_NHY + MIX_NHYC) hyena_ctx_task(q, l, t - MIX_NATT - MIX_NHY, smem);
        else if (t < MIX_NATT + MIX_NHY + MIX_NHYC + MIX_NWC) ph_wconv(q, l + 1, smem, t - (MIX_NATT + MIX_NHY + MIX_NHYC), MIX_NWC);
        else hy_filt_task(q, l + 1, t - (MIX_NATT + MIX_NHY + MIX_NHYC + MIX_NWC), smem);
    }
}

__device__ __forceinline__ void ph_final(const P& p, int bid, int nblk) {
    const int lane = tidx() & 63, wave = tidx() >> 6;
    const float* g = p.in[I_FINALG];
    for (int m = bid * 8 + wave; m < MLAT; m += nblk * 8) {
        float* src = p.out + (size_t)m * 1024;
        f32x4 v[4]; float s = 0.f;
#pragma unroll
        for (int j = 0; j < 4; ++j) { v[j] = *(const f32x4*)(src + 256 * j + 4 * lane); s += v[j].x * v[j].x + v[j].y * v[j].y + v[j].z * v[j].z + v[j].w * v[j].w; }
        s = wave_sum(s);
        float rs = rsqrtf(s * (1.0f / 1024.0f) + 1e-6f);
#pragma unroll
        for (int j = 0; j < 4; ++j) { f32x4 gg = *(const f32x4*)(g + 256 * j + 4 * lane); f32x4 o; o.x = v[j].x * rs * gg.x; o.y = v[j].y * rs * gg.y; o.z = v[j].z * rs * gg.z; o.w = v[j].w * rs * gg.w; *(f32x4*)(src + 256 * j + 4 * lane) = o; }
    }
}

#define LAS __attribute__((address_space(3)))
#define XB_TMO      128
#define XB_XCNT(j)  (256  + 64 * (j))
#define XB_XSUB(j)  (1280 + 64 * (j))
#define XB_XGEN(j)  (2304 + 64 * (j))
#define XB_TOP      3328
#define XB_TOPGEN   3392
#define XCD_BAR_WORDS 3456
#define XB_SPIN_CAP (1u << 18)

__device__ __forceinline__ unsigned xb_ld(unsigned* p)              { return __hip_atomic_load(p, __ATOMIC_RELAXED, __HIP_MEMORY_SCOPE_AGENT); }
__device__ __forceinline__ unsigned xb_add(unsigned* p, unsigned v) { return __hip_atomic_fetch_add(p, v, __ATOMIC_RELAXED, __HIP_MEMORY_SCOPE_AGENT); }
__device__ __forceinline__ unsigned xb_xcc_id() { return (unsigned)__builtin_amdgcn_s_getreg((3 << 11) | 20) & 0xFu; }
#define XB_SPIN(cond, bar) do { unsigned _sp = 0; while (cond) { __builtin_amdgcn_s_sleep(1); \
    if ((++_sp & 255u) == 0u) { if (xb_ld(&(bar)[XB_TMO])) break; if (_sp > XB_SPIN_CAP) { atomicAdd(&(bar)[XB_TMO], 1u); break; } } } } while (0)

struct XcdBarrier {
    unsigned* bar; unsigned x;
    volatile LAS unsigned* st;
};

__device__ __forceinline__ XcdBarrier xcd_barrier_post(unsigned* bar, volatile LAS unsigned* st) {
    XcdBarrier b; b.bar = bar; b.x = xb_xcc_id(); b.st = st;
    if (threadIdx.x == 0) (void)xb_add(&bar[XB_XCNT(b.x)], 1u);
    return b;
}
__device__ __forceinline__ void xcd_barrier_complete(unsigned* bar, unsigned x, unsigned& nloc, unsigned& nx) {
    const unsigned G = gridDim.x * gridDim.y * gridDim.z;
    unsigned sum, cnt, mine, sp = 0u;
    for (;;) {
        sum = 0u; cnt = 0u; mine = 0u;
#pragma unroll
        for (unsigned j = 0; j < 16; ++j) { const unsigned c = xb_ld(&bar[XB_XCNT(j)]); sum += c; cnt += (c > 0u) ? 1u : 0u; mine = (j == x) ? c : mine; }
        if (sum == G) break;
        __builtin_amdgcn_s_sleep(1);
        if ((++sp & 255u) == 0u) { if (xb_ld(&bar[XB_TMO])) break; if (sp > XB_SPIN_CAP) { atomicAdd(&bar[XB_TMO], 1u); break; } }
    }
    nloc = mine > 0u ? mine : 1u; nx = cnt > 0u ? cnt : 1u;
}

__device__ __forceinline__ void xcd_barrier(const XcdBarrier& b) {
    asm volatile("s_waitcnt vmcnt(0)" ::: "memory");
    __syncthreads();
    if (threadIdx.x == 0) {
        unsigned* bar = b.bar;
        __builtin_amdgcn_s_waitcnt(0);
        unsigned nloc = b.st[0], nx = b.st[1];
        if (nloc == 0u) { xcd_barrier_complete(bar, b.x, nloc, nx); b.st[0] = nloc; b.st[1] = nx; }
        const unsigned old = xb_add(&bar[XB_XSUB(b.x)], 1u);
        const unsigned gen = old / nloc;
        if (old + 1u == (gen + 1u) * nloc) {
            __builtin_amdgcn_fence(__ATOMIC_RELEASE, "agent");
            asm volatile("s_waitcnt vmcnt(0)" ::: "memory");
            const unsigned og = xb_add(&bar[XB_TOP], 1u);
            const unsigned tg = og / nx;
            if (og + 1u == (tg + 1u) * nx) xb_add(&bar[XB_TOPGEN], 1u);
            else XB_SPIN(xb_ld(&bar[XB_TOPGEN]) == tg, bar);
            __builtin_amdgcn_fence(__ATOMIC_ACQUIRE, "agent");
            xb_add(&bar[XB_XGEN(b.x)], 1u);
            asm volatile("s_waitcnt vmcnt(0)" ::: "memory");
        } else {
            XB_SPIN(xb_ld(&bar[XB_XGEN(b.x)]) == gen, bar);
            __builtin_amdgcn_fence(__ATOMIC_ACQUIRE, "agent");
            asm volatile("s_waitcnt vmcnt(0)" ::: "memory");
        }
    }
    __syncthreads();
}

__global__ void __launch_bounds__(NT) mega(KP kp) {
    extern __shared__ __attribute__((aligned(16))) unsigned char smem[];
    cg::grid_group grid = cg::this_grid();
    const int bid = blockIdx.x, nblk = gridDim.x;
    volatile LAS unsigned* xst = (volatile LAS unsigned*)((LAS unsigned char*)smem + LDS_BYTES - 32);
    if (threadIdx.x < 2) xst[threadIdx.x] = 0u;
    __syncthreads();
    XcdBarrier xbar = xcd_barrier_post((unsigned*)(kp.ws + WS_CTL) + 1024, xst);
    P q; q.in.t = (intab_t)__builtin_amdgcn_kernarg_segment_ptr(); q.out = kp.out; q.ws = kp.ws;
    FENCE(q); ph_modv(q, smem, bid, nblk);
    FENCE(q); ph_tables(q, bid, nblk);
    FENCE(q); ph_wconv(q, 0, smem, bid, nblk);
    FENCE(q); ph_hy_mlp(q, 0, smem, bid, nblk);
    grid.sync();
    for (int l = 0; l < DEPTH; ++l) {
        FENCE(q); ph_norm(q, l, bid, nblk);
        if (l == 0) { FENCE(q); ph_hraw(q, 0, bid, nblk); }
        xcd_barrier(xbar);
        FENCE(q);
        { pg8::Gemm g{(const bf16*)(q.ws + WS_HMIX), (const bf16*)(q.ws + ((l & 1) ? WS_WINT2 : WS_WINT)), MROWS, 3840, 1024}; pg8::StaticOrder S; S.init(MROWS, 3840, nblk, bid);
          EpiIn E{q.ws}; pg8::gemm_phase<EpiIn, pg8::StaticOrder, true, true>((PG8_LAS unsigned char*)smem, g, S, E); }
        if (l + 1 < DEPTH) { FENCE(q); ph_hy_mlp(q, l + 1, smem, bid, nblk); }
        if (l == 0) { FENCE(q); ph_hy_filt(q, 0, smem, bid, nblk); }
        xcd_barrier(xbar);
        FENCE(q); ph_rw_prep(q, l, smem, bid, nblk);
        FENCE(q); ph_attn_prep(q, l, bid, nblk);
        FENCE(q); ph_hy_prep(q, l, smem, bid, nblk);
        if (l + 1 < DEPTH) { FENCE(q); ph_hraw(q, l + 1, bid, nblk); }
        xcd_barrier(xbar);
#if PROBE
        unsigned long long tm0 = __builtin_amdgcn_s_memrealtime();
#endif
        FENCE(q); ph_mixer(q, l, smem, bid, nblk);
#if PROBE
        if (bid == 200 && l == 1 && tidx() == 0) ((unsigned long long*)(q.ws + WS_CTL))[256 + 3] = __builtin_amdgcn_s_memrealtime() - tm0;
#endif
        xcd_barrier(xbar);
#if PROBE
        if (bid == 0 && l == 1 && tidx() == 0) ((unsigned long long*)(q.ws + WS_CTL))[256 + 2] = __builtin_amdgcn_s_memrealtime() - tm0;
#endif
        if (l < DEPTH - 1) {
            FENCE(q); ph_rw_readout(q, l, MLAT, MROWS, bid, nblk);
            unsigned* cctr = (unsigned*)(q.ws + WS_CTL) + 320 + 16 * l;
            asm volatile("s_waitcnt vmcnt(0)" ::: "memory");
            __syncthreads();
            if (threadIdx.x == 0) { __builtin_amdgcn_fence(__ATOMIC_RELEASE, "agent"); asm volatile("s_waitcnt vmcnt(0)" ::: "memory"); (void)xb_add(cctr, 1u); }
            if (bid < 32) {
                if (threadIdx.x == 0) { XB_SPIN(xb_ld(cctr) < (unsigned)nblk, xbar.bar); __builtin_amdgcn_fence(__ATOMIC_ACQUIRE, "agent"); asm volatile("s_waitcnt vmcnt(0)" ::: "memory"); }
                __syncthreads();
                FENCE(q);
                pg8::Gemm g{(const bf16*)(q.ws + WS_MIX), (const bf16*)(q.ws + ((l & 1) ? WS_WOUTT2 : WS_WOUTT)), MROWS, 1024, 1024}; pg8::OneUnit S{MLAT / 256 + (bid >> 2), bid & 3};
                EpiOut E{l == 0 ? q.in[I_X] : q.out, l == 0 ? q.in[I_CTX] : (const float*)(q.ws + WS_CTXS), q.out, (float*)(q.ws + WS_CTXS), (const float*)(q.ws + WS_MODV) + (size_t)l * 9 * 3072 + 2048};
                pg8::gemm_phase<EpiOut, pg8::OneUnit, true, true>((PG8_LAS unsigned char*)smem, g, S, E);
            } else {
                FENCE(q); ph_rw_readout(q, l, 0, MLAT, bid - 32, nblk - 32);
                FENCE(q); ph_hy_out(q, smem, bid - 32, nblk - 32);
            }
        } else {
            FENCE(q); ph_rw_readout(q, l, 0, MLAT, bid, nblk);
            FENCE(q); ph_hy_out(q, smem, bid, nblk);
        }
        xcd_barrier(xbar);
        FENCE(q);
        { const int Mo = MLAT;
          pg8::Gemm g{(const bf16*)(q.ws + WS_MIX), (const bf16*)(q.ws + ((l & 1) ? WS_WOUTT2 : WS_WOUTT)), Mo, 1024, 1024}; pg8::StaticOrder S; S.init(Mo, 1024, nblk, bid);
          EpiOut E{l == 0 ? q.in[I_X] : q.out, l == 0 ? q.in[I_CTX] : (const float*)(q.ws + WS_CTXS), q.out, (float*)(q.ws + WS_CTXS), (const float*)(q.ws + WS_MODV) + (size_t)l * 9 * 3072 + 2048};
          pg8::gemm_phase<EpiOut, pg8::StaticOrder, true, true>((PG8_LAS unsigned char*)smem, g, S, E); }
        xcd_barrier(xbar);
    }
    FENCE(q); ph_final(q, bid, nblk);
#if PROBE
    xcd_barrier(xbar);
    if (bid == 0 && tidx() == 0) q.out[0] = 1000.0f * (float)((unsigned long long*)(q.ws + WS_CTL))[256 + PROBE];
#endif
}

extern "C" void kernel_launch(void* const* d_in, const int* in_sizes, int n_in, void* d_out, int out_size, void* d_ws, size_t ws_size, hipStream_t stream) {
    if (n_in != 31 || ws_size < WS_END) { fprintf(stderr, "kernel_launch: unexpected inputs (n_in %d, ws %zu)\n", n_in, ws_size); return; }
    static int grid_blocks = 0;
    if (!grid_blocks) {
        int dev = 0, cus = 0, per_cu = 0;
        (void)hipGetDevice(&dev);
        (void)hipDeviceGetAttribute(&cus, hipDeviceAttributeMultiprocessorCount, dev);
        (void)hipFuncSetAttribute((const void*)mega, hipFuncAttributeMaxDynamicSharedMemorySize, LDS_BYTES);
        (void)hipOccupancyMaxActiveBlocksPerMultiprocessor(&per_cu, (const void*)mega, NT, LDS_BYTES);
        if (per_cu < 1) { fprintf(stderr, "kernel_launch: occupancy query says %d blocks per CU\n", per_cu); per_cu = 1; }
        grid_blocks = cus;
    }
    KP p{};
    for (int i = 0; i < 31; ++i) p.in[i] = (const float*)d_in[i];
    p.out = (float*)d_out; p.ws = (unsigned char*)d_ws;
    (void)hipMemsetAsync((unsigned char*)d_ws + WS_CTL, 0, 65536, stream);
    void* args[] = {&p};
    hipError_t e = hipLaunchCooperativeKernel((const void*)mega, dim3(grid_blocks), dim3(NT), args, LDS_BYTES, stream);
    if (e != hipSuccess) fprintf(stderr, "cooperative launch failed: %s (grid %d)\n", hipGetErrorString(e), grid_blocks);
}
```

```cpp
#include <hip/hip_runtime.h>
#include <hip/hip_cooperative_groups.h>
#include <stdint.h>
#include <stdio.h>
namespace cg = cooperative_groups;

#ifndef PROBE
#define PROBE 0
#endif
#ifndef EN_A
#define EN_A 1
#endif
#ifndef EN_B
#define EN_B 1
#endif
#ifndef EN_C
#define EN_C 1
#endif
#ifndef EN_D
#define EN_D 1
#endif

typedef unsigned short bf16;
typedef short bf16x8 __attribute__((ext_vector_type(8)));
typedef float f32x16 __attribute__((ext_vector_type(16)));
typedef float f32x4 __attribute__((ext_vector_type(4)));
typedef unsigned u32x4 __attribute__((ext_vector_type(4)));
typedef unsigned u32x2 __attribute__((ext_vector_type(2)));

constexpr int NT = 512;
constexpr int NB = 8, LAT = 4096, CTX = 256, DM = 1024, DEPTH = 4;
constexpr int MLAT = NB * LAT, MCTX = NB * CTX, MROWS = MLAT + MCTX, DIN = 3712;
constexpr int SKV = CTX + LAT;
constexpr int NFFT = 8192;

constexpr size_t MiB = 1u << 20;
constexpr size_t WS_CTL = 0;
constexpr size_t WS_MODV = 1 * MiB;
constexpr size_t WS_TW = 2 * MiB;
constexpr size_t WS_ROPE = 3 * MiB;
constexpr size_t WS_H2 = 4 * MiB;
constexpr size_t WS_HCTX = 6 * MiB;
constexpr size_t WS_WINT = 7 * MiB;
constexpr size_t WS_WOUTT = 15 * MiB;
constexpr size_t WS_CTXS = 17 * MiB;
constexpr size_t WS_KHAT = 25 * MiB;
constexpr size_t KHAT_COPY = 16 * MiB;
constexpr size_t WS_VTW = 57 * MiB;
constexpr size_t WS_VTF = 66 * MiB;
constexpr size_t WS_HMIX = 75 * MiB;
constexpr size_t WS_ZHY = 143 * MiB;
constexpr size_t WS_ZRW = 194 * MiB;
constexpr size_t WS_MIX = WS_ZHY;
constexpr size_t WS_YF = WS_MIX + 68 * MiB;
constexpr size_t WS_YB = WS_YF + 17 * MiB;
static_assert(WS_YB + 17 * MiB <= 254 * MiB, "Y overlay");
constexpr size_t HYT_CTX_OFF = (size_t)NB * 4 * 256 * LAT;
constexpr size_t WS_ZWA = 254 * MiB;
constexpr size_t WS_ZFA = 280 * MiB;
constexpr size_t WS_GATES = 306 * MiB;
constexpr size_t WS_RW = 374 * MiB;
constexpr size_t RW_STRIDE = 17 * MiB;
constexpr size_t WS_WINT2 = WS_RW + 7 * RW_STRIDE;
constexpr size_t WS_WOUTT2 = WS_WINT2 + 8 * MiB;
constexpr size_t WS_HCTX2 = WS_WOUTT2 + 2 * MiB;
constexpr size_t WS_HRAW = WS_HCTX2 + 1 * MiB;
constexpr size_t WS_END = WS_HRAW + 8 * MiB;
constexpr size_t WS_HRAWC = 5 * MiB + 256 * 1024;
static_assert(WS_END <= 512 * MiB, "workspace");
static_assert((size_t)MROWS * 256 * 2 <= RW_STRIDE, "rw stride");

constexpr int LDS_BYTES = 144 * 1024;

typedef __attribute__((address_space(1))) const float* gcfp;
typedef __attribute__((address_space(1))) float* gfp;
typedef __attribute__((address_space(1))) unsigned char* gu8p;
typedef const gcfp __attribute__((address_space(4)))* intab_t;
struct InTab { intab_t t; __device__ __forceinline__ const float* operator[](int i) const { return (const float*)t[i]; } };
struct P { InTab in; float* out; unsigned char* ws; };
struct KP { const float* in[31]; float* out; unsigned char* ws; };
#define FENCE(q) do { gu8p w_ = (gu8p)q.ws; gfp o_ = (gfp)q.out; asm volatile("" : "+s"(w_), "+s"(o_), "+s"(q.in.t)); q.ws = (unsigned char*)w_; q.out = (float*)o_; } while (0)
enum { I_X = 0, I_C, I_CTX, I_CCTX, I_MODW, I_MODB, I_NORMG, I_WIN, I_WOUT, I_HYCONV, I_HYFW1, I_HYFB1, I_HYFREQ, I_HYFW2, I_HYFB2, I_HYFW3,
       I_HYBIAS, I_RWCONV, I_RWW0, I_RWWUP, I_RWA0, I_RWAUP, I_RWKK, I_RWKA, I_RWRK, I_RWLNG, I_RWLNB, I_WASINK, I_FAQN, I_FAKN, I_FINALG };

typedef __bf16 bf16x2q __attribute__((ext_vector_type(2)));
typedef float f32x2q __attribute__((ext_vector_type(2)));
__device__ __forceinline__ bf16 f2bf(float f) { return __builtin_bit_cast(unsigned short, (__bf16)f); }
__device__ __forceinline__ float bf2f(bf16 h) { return __uint_as_float(((unsigned)h) << 16); }
__device__ __forceinline__ unsigned pk2(float lo, float hi) { return __builtin_bit_cast(unsigned, __builtin_convertvector((f32x2q){lo, hi}, bf16x2q)); }
__device__ __forceinline__ unsigned cvtpk(float lo, float hi) { unsigned r; asm volatile("v_cvt_pk_bf16_f32 %0, %1, %2" : "=v"(r) : "v"(lo), "v"(hi)); return r; }
__device__ __forceinline__ bf16 cvt1(float x) { return __builtin_bit_cast(unsigned short, (__bf16)x); }
typedef __bf16 bf16x2n __attribute__((ext_vector_type(2)));
typedef float f32x2n __attribute__((ext_vector_type(2)));
__device__ __forceinline__ unsigned cvtpk_n(float lo, float hi) { return __builtin_bit_cast(unsigned, __builtin_convertvector((f32x2n){lo, hi}, bf16x2n)); }
__device__ __forceinline__ float bflo(unsigned u) { return __uint_as_float(u << 16); }
__device__ __forceinline__ float bfhi(unsigned u) { return __uint_as_float(u & 0xffff0000u); }
__device__ __forceinline__ float sum8(float x) {
    x += __int_as_float(__builtin_amdgcn_update_dpp(0, __float_as_int(x), 0xB1, 0xF, 0xF, true));
    x += __int_as_float(__builtin_amdgcn_update_dpp(0, __float_as_int(x), 0x4E, 0xF, 0xF, true));
    x += __int_as_float(__builtin_amdgcn_update_dpp(0, __float_as_int(x), 0x141, 0xF, 0xF, true));
    return x;
}
__device__ __forceinline__ float ftanh(float x) { const float e = __expf(-2.0f * fabsf(x)); const float t = (1.0f - e) * __builtin_amdgcn_rcpf(1.0f + e); return x < 0.f ? -t : t; }
__device__ __forceinline__ float siluf(float x) { return x * __builtin_amdgcn_rcpf(1.0f + __expf(-x)); }
__device__ __forceinline__ int tidx() { int t = threadIdx.x; asm volatile("" : "+v"(t)); return t; }
__device__ __forceinline__ float wave_sum(float x) {
    x += __int_as_float(__builtin_amdgcn_update_dpp(0, __float_as_int(x), 0xB1, 0xF, 0xF, true));
    x += __int_as_float(__builtin_amdgcn_update_dpp(0, __float_as_int(x), 0x4E, 0xF, 0xF, true));
    x += __int_as_float(__builtin_amdgcn_update_dpp(0, __float_as_int(x), 0x141, 0xF, 0xF, true));
    x += __int_as_float(__builtin_amdgcn_update_dpp(0, __float_as_int(x), 0x140, 0xF, 0xF, true));
    { const unsigned u = __float_as_uint(x); auto r = __builtin_amdgcn_permlane16_swap(u, u, false, false); x = __uint_as_float(r[0]) + __uint_as_float(r[1]); }
    { const unsigned u = __float_as_uint(x); auto r = __builtin_amdgcn_permlane32_swap(u, u, false, false); x = __uint_as_float(r[0]) + __uint_as_float(r[1]); }
    return x;
}
__device__ __forceinline__ float red_rev(float x) { float r = x * 0.15915494309189535f; return r - rintf(r); }
__device__ __forceinline__ float fsin(float x) { return __builtin_amdgcn_sinf(red_rev(x)); }
__device__ __forceinline__ float fcos(float x) { return __builtin_amdgcn_cosf(red_rev(x)); }
__device__ __forceinline__ int row_lat(int b, int t) { return b * LAT + t; }
__device__ __forceinline__ int row_ctx(int b, int t) { return MLAT + b * CTX + t; }

__device__ __forceinline__ void ph_modv(const P& p, unsigned char* smem, int bid, int nblk) {
    float* sc = (float*)smem;
    float* red = sc + 9 * 1024;
    const float* c = p.in[I_C]; const float* cc = p.in[I_CCTX];
    const int tid = tidx();
    for (int i = tid; i < 9 * 1024; i += NT) { float v = (i < 8192) ? c[i] : cc[i - 8192]; sc[i] = siluf(v); }
    __syncthreads();
    const int nq = tid % 12, kg = tid / 12;
    for (int chunk = bid; chunk < 256; chunk += nblk) {
        const int l = chunk >> 6, n0 = (chunk & 63) * 48 + 4 * nq;
        f32x4 acc[9];
#pragma unroll
        for (int i = 0; i < 9; ++i) acc[i] = (f32x4){0.f, 0.f, 0.f, 0.f};
        if (kg < 42) {
            const float* W = p.in[I_MODW] + (size_t)l * 1024 * 3072 + n0;
#pragma unroll 5
            for (int k = kg; k < 1024; k += 42) {
                const f32x4 w = *(const f32x4*)(W + (size_t)k * 3072);
#pragma unroll
                for (int i = 0; i < 9; ++i) { const float sv = sc[i * 1024 + k]; acc[i] += sv * w; }
            }
#pragma unroll
            for (int i = 0; i < 9; ++i) *(f32x4*)(red + (kg * 9 + i) * 48 + 4 * nq) = acc[i];
        }
        __syncthreads();
        if (tid < 432) {
            const int i = tid / 48, n2 = (chunk & 63) * 48 + (tid % 48);
            float sum = p.in[I_MODB][l * 3072 + n2];
#pragma unroll 6
            for (int g = 0; g < 42; ++g) sum += red[(g * 9 + i) * 48 + (tid % 48)];
            ((float*)(p.ws + WS_MODV))[(size_t)l * 9 * 3072 + i * 3072 + n2] = sum;
        }
        __syncthreads();
    }
}

__device__ __forceinline__ void ph_tables(const P& p, int bid, int nblk) {
    for (int gid = bid * NT + tidx(); gid < 4096; gid += nblk * NT) {
        float rev = (float)gid * (1.0f / 8192.0f);
        ((float2*)(p.ws + WS_TW))[gid] = make_float2(__builtin_amdgcn_cosf(rev), -__builtin_amdgcn_sinf(rev));
    }
    for (int i = bid * NT + tidx(); i < 4096 * 32; i += nblk * NT) {
        int pos = i >> 5, sf = i & 31, s = sf >> 4, f = sf & 15;
        float inv = exp2f(-(float)f * (13.287712379549449f / 16.0f));
        float ang = (float)(s == 0 ? (pos >> 6) : (pos & 63)) * inv;
        ((float2*)(p.ws + WS_ROPE))[i] = make_float2(fcos(ang), fsin(ang));
    }
}

__device__ __forceinline__ void ph_wconv(const P& p, int l, unsigned char* smem, int bid, int nblk) {
    float* sm = (float*)smem;
    const int T1 = 16 * (DIN / 64), T2 = 16 * 16;
    const int tid = tidx();
    auto src_of = [&](int t, const float*& W, int& N, bf16*& WT, int& tile) {
        if (t < T1) { W = p.in[I_WIN] + (size_t)l * 1024 * DIN; N = DIN; WT = (bf16*)(p.ws + ((l & 1) ? WS_WINT2 : WS_WINT)); tile = t; }
        else { W = p.in[I_WOUT] + (size_t)l * 1024 * 1024; N = 1024; WT = (bf16*)(p.ws + ((l & 1) ? WS_WOUTT2 : WS_WOUTT)); tile = t - T1; }
    };
    float vn[8];
    auto tload = [&](int t) {
        const float* W; int N; bf16* WT; int tile; src_of(t, W, N, WT, tile);
        const int ntn = N / 64, k0 = (tile / ntn) * 64, n0 = (tile % ntn) * 64;
#pragma unroll
        for (int i = 0; i < 8; ++i) { const int idx = i * NT + tid, r = idx >> 6, c = idx & 63; vn[i] = W[(size_t)(k0 + r) * N + n0 + c]; }
    };
    if (bid < T1 + T2) tload(bid);
    for (int t = bid; t < T1 + T2; t += nblk) {
        const float* W; int N; bf16* WT; int tile; src_of(t, W, N, WT, tile);
        const int ntn = N / 64, k0 = (tile / ntn) * 64, n0 = (tile % ntn) * 64;
#pragma unroll
        for (int i = 0; i < 8; ++i) { const int idx = i * NT + tid, r = idx >> 6, c = idx & 63; sm[r * 65 + c] = vn[i]; }
        if (t + nblk < T1 + T2) tload(t + nblk);
        __syncthreads();
#pragma unroll
        for (int i = 0; i < 8; ++i) { const int idx = i * NT + tid, n = idx >> 6, k = idx & 63; WT[(size_t)(n0 + n) * 1024 + k0 + k] = cvt1(sm[k * 65 + n]); }
        __syncthreads();
    }
}

__device__ __forceinline__ void ph_norm(const P& p, int l, int bid, int nblk) {
    const int lane = tidx() & 63, wave = tidx() >> 6;
    const float* modv = (const float*)(p.ws + WS_MODV) + (size_t)l * 9 * 3072;
    const float* g = p.in[I_NORMG] + l * 1024;
    bf16* H = (bf16*)(p.ws + WS_HMIX);
    f32x4 gq[4];
#pragma unroll
    for (int j = 0; j < 4; ++j) gq[j] = *(const f32x4*)(g + 256 * j + 4 * lane);
    for (int m = bid * 8 + wave; m < MROWS; m += nblk * 8) {
        const int mi = (m < MLAT) ? m / LAT : 8;
        const float* mv = modv + mi * 3072;
        f32x4 v[4], shv[4], scv[4]; float s = 0.f;
        if (m < MLAT && l > 0) {
            const bf16* sb = (const bf16*)p.out + (size_t)m * 1024;
            u32x2 r[4];
#pragma unroll
            for (int j = 0; j < 4; ++j) { r[j] = *(const u32x2*)(sb + 256 * j + 4 * lane); shv[j] = *(const f32x4*)(mv + 256 * j + 4 * lane); scv[j] = *(const f32x4*)(mv + 1024 + 256 * j + 4 * lane); }
#pragma unroll
            for (int j = 0; j < 4; ++j) { v[j].x = bflo(r[j].x); v[j].y = bfhi(r[j].x); v[j].z = bflo(r[j].y); v[j].w = bfhi(r[j].y); }
        } else {
            const float* src = (m < MLAT) ? p.in[I_X] + (size_t)m * 1024 : (l == 0 ? p.in[I_CTX] : (const float*)(p.ws + WS_CTXS)) + (size_t)(m - MLAT) * 1024;
#pragma unroll
            for (int j = 0; j < 4; ++j) { v[j] = *(const f32x4*)(src + 256 * j + 4 * lane); shv[j] = *(const f32x4*)(mv + 256 * j + 4 * lane); scv[j] = *(const f32x4*)(mv + 1024 + 256 * j + 4 * lane); }
            if (m < MLAT) {
                bf16* xb = (bf16*)p.out + (size_t)m * 1024;
#pragma unroll
                for (int j = 0; j < 4; ++j) { u32x2 w; w.x = pk2(v[j].x, v[j].y); w.y = pk2(v[j].z, v[j].w); *(u32x2*)(xb + 256 * j + 4 * lane) = w; }
            }
        }
#pragma unroll
        for (int j = 0; j < 4; ++j) s += v[j].x * v[j].x + v[j].y * v[j].y + v[j].z * v[j].z + v[j].w * v[j].w;
        s = wave_sum(s);
        float rs = rsqrtf(s * (1.0f / 1024.0f) + 1e-6f);
        __builtin_amdgcn_sched_barrier(0);
#pragma unroll
        for (int j = 0; j < 4; ++j) {
            int c0 = 256 * j + 4 * lane;
            const f32x4 gg = gq[j], sh = shv[j], sc = scv[j];
            float o0 = v[j].x * rs * gg.x * (1.f + sc.x) + sh.x, o1 = v[j].y * rs * gg.y * (1.f + sc.y) + sh.y;
            float o2 = v[j].z * rs * gg.z * (1.f + sc.z) + sh.z, o3 = v[j].w * rs * gg.w * (1.f + sc.w) + sh.w;
            u32x2 w; w.x = pk2(o0, o1); w.y = pk2(o2, o3);
            *(u32x2*)(H + (size_t)m * 1024 + c0) = w;
        }
    }
}

__device__ __forceinline__ void ph_hy_mlp(const P& p, int l, unsigned char* smem, int bid, int nblk) {
    float (*z)[36] = (float (*)[36])smem; float (*h1)[64] = (float (*)[64])(smem + 8 * 36 * 4);
    const int j = tidx() & 63, rr = tidx() >> 6;
    const float* fw1 = p.in[I_HYFW1] + l * 33 * 64; const float* fb1 = p.in[I_HYFB1] + l * 64; const float* fq = p.in[I_HYFREQ] + l * 64;
    const float* fw2 = p.in[I_HYFW2] + l * 64 * 64; const float* fb2 = p.in[I_HYFB2] + l * 64;
    float* H2 = (float*)(p.ws + WS_H2);
    if (bid * 8 >= 4352) return;
    float w1[33], w2[64];
#pragma unroll
    for (int i = 0; i < 33; ++i) w1[i] = fw1[i * 64 + j];
#pragma unroll
    for (int i = 0; i < 64; ++i) w2[i] = fw2[i * 64 + j];
    const float b1 = fb1[j], b2 = fb2[j], fqj = fq[j];
    for (int r0 = bid * 8; r0 < 4352; r0 += nblk * 8) {
        int row = r0 + rr; int L = row < 4096 ? 4096 : 256; int t = row < 4096 ? row : row - 4096;
        if (j < 33) {
            float val;
            if (j == 0) val = (float)t / (float)(L - 1);
            else { int jj = (j - 1) & 15; float f = 1e-4f + (float)jj * ((15.0f - 1e-4f) / 15.0f); float w = (6.283185307179586f / (float)L) * (float)t; float a = f * w; val = (j <= 16) ? fcos(a) : fsin(a); }
            z[rr][j] = val;
        }
        __syncthreads();
        float a = b1;
#pragma unroll
        for (int i = 0; i < 33; ++i) a += z[rr][i] * w1[i];
        h1[rr][j] = fsin(fqj * a);
        __syncthreads();
        float b = b2;
#pragma unroll
        for (int i = 0; i < 64; ++i) b += h1[rr][i] * w2[i];
        H2[(size_t)row * 64 + j] = fsin(fqj * b);
        __syncthreads();
    }
}

#define PADI(i) ((i) + ((i) >> 5))
constexpr int XLEN = NFFT + NFFT / 32;
__device__ __forceinline__ float2 cmul(float2 a, float2 b) { return make_float2(a.x * b.x - a.y * b.y, a.x * b.y + a.y * b.x); }
__device__ __forceinline__ float2 cmulc(float2 a, float2 b) { return make_float2(a.x * b.x + a.y * b.y, a.y * b.x - a.x * b.y); }

#define C8_RE(k) ((k) == 0 ? 1.0f : (k) == 1 ? 0.9238795325112867f : (k) == 2 ? 0.7071067811865476f : (k) == 3 ? 0.3826834323650898f : (k) == 4 ? 0.0f : (k) == 5 ? -0.3826834323650898f : (k) == 6 ? -0.7071067811865476f : -0.9238795325112867f)
#define C8_IM(k) ((k) == 0 ? 0.0f : (k) == 1 ? -0.3826834323650898f : (k) == 2 ? -0.7071067811865476f : (k) == 3 ? -0.9238795325112867f : (k) == 4 ? -1.0f : (k) == 5 ? -0.9238795325112867f : (k) == 6 ? -0.7071067811865476f : -0.3826834323650898f)
template <int PB, bool INV>
__device__ __forceinline__ void fft_pass(float2* X, const float2* twA, const float2* twB) {
    constexpr int NS = 4, R = 16;
    const int g = tidx();
    const int base_lo = g & ((1 << PB) - 1), base_hi = (g >> PB) << (PB + NS);
    float2 v[R];
#pragma unroll
    for (int j = 0; j < R; ++j) v[j] = X[PADI(base_hi | (j << PB) | base_lo)];
    float2 wb[4];
    if (PB == 9) wb[3] = twA[base_lo];
    else if (PB == 5) wb[3] = twB[base_lo];
    else wb[3] = base_lo ? make_float2(0.9807852804032304f, -0.19509032201612825f) : make_float2(1.0f, 0.0f);
#pragma unroll
    for (int q = 2; q >= 0; --q) wb[q] = make_float2(wb[q + 1].x * wb[q + 1].x - wb[q + 1].y * wb[q + 1].y, 2.0f * wb[q + 1].x * wb[q + 1].y);
#pragma unroll
    for (int qq = 0; qq < NS; ++qq) {
        const int q = INV ? qq : (NS - 1 - qq);
        float2 tws[8];
#pragma unroll
        for (int jl = 0; jl < (1 << q); ++jl) {
            const int k = jl << (3 - q);
            tws[jl] = (k == 0) ? wb[q] : cmul(wb[q], make_float2(C8_RE(k), C8_IM(k)));
        }
#pragma unroll
        for (int j = 0; j < R; ++j) {
            if (j & (1 << q)) continue;
            const int j2 = j | (1 << q);
            const float2 tw = tws[j & ((1 << q) - 1)];
            if (!INV) {
                float2 a = v[j], b = v[j2];
                v[j] = make_float2(a.x + b.x, a.y + b.y);
                v[j2] = cmul(make_float2(a.x - b.x, a.y - b.y), tw);
            } else {
                float2 a = v[j], b = cmulc(v[j2], tw);
                v[j] = make_float2(a.x + b.x, a.y + b.y);
                v[j2] = make_float2(a.x - b.x, a.y - b.y);
            }
        }
    }
#pragma unroll
    for (int j = 0; j < R; ++j) X[PADI(base_hi | (j << PB) | base_lo)] = v[j];
    __syncthreads();
}
__device__ __forceinline__ void fft_load_tw(float2* twA, const float2* twg) {
    const int t = tidx();
    twA[t] = twg[t];
    if (t < 32) twA[512 + t] = twg[16 * t];
}
__device__ __forceinline__ void fft_fwd_hi(float2* X, const float2* twA) { fft_pass<9, false>(X, twA, twA + 512); fft_pass<5, false>(X, twA, twA + 512); fft_pass<1, false>(X, twA, twA + 512); }
__device__ __forceinline__ void fft_inv_hi(float2* X, const float2* twA) { fft_pass<1, true>(X, twA, twA + 512); fft_pass<5, true>(X, twA, twA + 512); fft_pass<9, true>(X, twA, twA + 512); }

__device__ __forceinline__ void ph_hraw(const P& p, int l, int bid, int nblk) {
    const int tid = tidx(), lane = tid & 63, wave = tid >> 6, r = lane & 31, hh = lane >> 5;
    const float* H2 = (const float*)(p.ws + WS_H2);
    const float* fw3 = p.in[I_HYFW3] + (size_t)l * 64 * 1024;
    bf16* HR = (bf16*)(p.ws + WS_HRAW); bf16* HRC = (bf16*)(p.ws + WS_HRAWC);
    const int gw = bid * 8 + wave, nw = nblk * 8;
    const int ct = gw & 31;
    bf16x8 Af[4];
#pragma unroll
    for (int sI = 0; sI < 4; ++sI) {
        const float* u0 = fw3 + (size_t)(16 * sI + 8 * hh) * 1024 + ct * 32 + r;
        u32x4 w; w.x = cvtpk_n(u0[0], u0[1024]); w.y = cvtpk_n(u0[2048], u0[3072]); w.z = cvtpk_n(u0[4096], u0[5120]); w.w = cvtpk_n(u0[6144], u0[7168]);
        Af[sI] = __builtin_bit_cast(bf16x8, w);
    }
    for (int tt = gw >> 5; tt < 136; tt += nw >> 5) {
        const int t0 = tt * 32;
        f32x16 acc;
#pragma unroll
        for (int e = 0; e < 16; ++e) acc[e] = 0.f;
#pragma unroll
        for (int sI = 0; sI < 4; ++sI) {
            const float* hp = H2 + (size_t)(t0 + r) * 64 + 16 * sI + 8 * hh;
            const f32x4 h0 = *(const f32x4*)hp, h1 = *(const f32x4*)(hp + 4);
            u32x4 w; w.x = cvtpk_n(h0.x, h0.y); w.y = cvtpk_n(h0.z, h0.w); w.z = cvtpk_n(h1.x, h1.y); w.w = cvtpk_n(h1.z, h1.w);
            acc = __builtin_amdgcn_mfma_f32_32x32x16_bf16(Af[sI], __builtin_bit_cast(bf16x8, w), acc, 0, 0, 0);
        }
#pragma unroll
        for (int e = 0; e < 16; ++e) {
            const int col = ct * 32 + (e & 3) + 8 * (e >> 2) + 4 * hh, t = t0 + r;
            if (t < 4096) HR[(size_t)col * 4096 + t] = cvt1(acc[e]);
            else HRC[(size_t)col * 256 + (t - 4096)] = cvt1(acc[e]);
        }
    }
}

__device__ __forceinline__ void hy_filt_task(const P& p, int l, int task, unsigned char* smem) {
    float2* X = (float2*)smem;
    float* red = (float*)(smem + XLEN * 8);
    float2* tw = (float2*)(red + 8 + 128);
    fft_load_tw(tw, (const float2*)(p.ws + WS_TW));
    const bf16* HR = (const bf16*)(p.ws + WS_HRAW); const bf16* HRC = (const bf16*)(p.ws + WS_HRAWC);
    const int tid = tidx();
    {
        const bool isctx = task >= 512; const int oc = task & 511, o = oc >> 8, c = oc & 255;
        const float delta = fabsf(-3.0701134573253945f + (float)c * ((-15.350567286626973f + 3.0701134573253945f) / 255.0f));
        float asum = 0.f; float hf0 = 0.f, hb0 = 0.f;
        if (isctx) {
            if (tid < 256) {
                const float dec = __expf(-((float)tid / 255.0f) * delta);
                hf0 = bf2f(HRC[(size_t)(o * 512 + c) * 256 + tid]) * dec; hb0 = bf2f(HRC[(size_t)(o * 512 + 256 + c) * 256 + tid]) * dec;
                asum = fabsf(hf0) + fabsf(hb0);
            }
        } else {
            const int t0 = tid * 8;
            const u32x4 fv = *(const u32x4*)(HR + (size_t)(o * 512 + c) * 4096 + t0), bv = *(const u32x4*)(HR + (size_t)(o * 512 + 256 + c) * 4096 + t0);
#pragma unroll
            for (int j = 0; j < 8; ++j) {
                const int t = t0 + j;
                const float dec = __expf(-((float)t * (1.0f / 4095.0f)) * delta);
                const float a = ((j & 1) ? bfhi(fv[j >> 1]) : bflo(fv[j >> 1])) * dec, b = ((j & 1) ? bfhi(bv[j >> 1]) : bflo(bv[j >> 1])) * dec;
                asum += fabsf(a) + fabsf(b);
                X[PADI(t)] = make_float2(a, 0.f);
                const int m2 = (t == 0) ? 4096 : (NFFT - t);
                X[PADI(m2)] = make_float2(t == 0 ? 0.f : b, 0.f);
            }
        }
        asum = wave_sum(asum);
        if ((tid & 63) == 0) red[tid >> 6] = asum;
        __syncthreads();
        float tot = 0.f;
#pragma unroll
        for (int i = 0; i < 8; ++i) tot += red[i];
        const float inv = 1.0f / tot;
        if (isctx) {
            float* HC = (float*)(p.ws + ((l & 1) ? WS_HCTX2 : WS_HCTX));
            if (tid < 256) { HC[((o * 2 + 0) * 256 + c) * 256 + tid] = hf0 * inv; HC[((o * 2 + 1) * 256 + c) * 256 + tid] = hb0 * inv; }
            __syncthreads();
            return;
        }
        const float sc = inv * (1.0f / (float)NFFT);
        __syncthreads();
        fft_fwd_hi(X, tw);
        unsigned* KH = (unsigned*)(p.ws + WS_KHAT + (size_t)(l & 1) * KHAT_COPY) + (size_t)oc * NFFT;
        for (int i = 0; i < 8; ++i) {
            int pidx = tid + NT * i; float2 a = X[PADI(2 * pidx)], b = X[PADI(2 * pidx + 1)];
            u32x2 w; w.x = cvtpk_n((a.x + b.x) * sc, (a.y + b.y) * sc); w.y = cvtpk_n((a.x - b.x) * sc, (a.y - b.y) * sc);
            *(u32x2*)(KH + 2 * pidx) = w;
        }
        __syncthreads();
    }
}

__device__ __forceinline__ void ph_hy_filt(const P& p, int l, unsigned char* smem, int bid, int nblk) {
    unsigned* ctr = (unsigned*)(p.ws + WS_CTL) + 64 * (8 + l);
    volatile int* s_task = (volatile int*)(smem + LDS_BYTES - 16);
    for (;;) {
        __syncthreads();
        if (tidx() == 0) *s_task = (int)atomicAdd(ctr, 1u);
        __syncthreads();
        const int task = __builtin_amdgcn_readfirstlane(*s_task);
        if (task >= 1024) break;
        hy_filt_task(p, l, task, smem);
    }
}
namespace pg8 {
#define PG8_LAS __attribute__((address_space(3)))
typedef unsigned short bf16_t;
typedef short bf16x8 __attribute__((ext_vector_type(8)));
typedef float f32x4 __attribute__((ext_vector_type(4)));
typedef unsigned u32x4 __attribute__((ext_vector_type(4)));
constexpr int BM = 256, BK = 64, HALF = 128, HTB = HALF * BK * 2  , STAGE_BYTES = 8 * HTB, NXCD = 8, WGM = 8;

__host__ __device__ __forceinline__ int lds_byte(int r, int c) { const int st = (r >> 4) * 2 + (c >> 5), rr = r & 15, cc = c & 31, ob = rr * 64 + cc * 2; return st * 1024 + (ob ^ (((ob >> 9) & 1) << 5)); }
__host__ __device__ __forceinline__ void stage_rc(int b, int& R, int& C) { const int st = b / 1024, sb = b % 1024, swz = sb ^ (((sb >> 9) & 1) << 5); R = (st >> 1) * 16 + swz / 64; C = (st & 1) * 32 + (swz % 64) / 2; }
__host__ __device__ __forceinline__ int perm32(int rho) { const int n = rho >> 4, i = rho & 15; return 8 * (i >> 2) + 4 * n + (i & 3); }

struct Unit { int pm, pn; };
struct Gemm { const bf16_t* A; const bf16_t* Bt; int M, N, K; };

struct StaticOrder {
    int nM, nN, nwg, G, c;
    __host__ __device__ void init(int M, int N, int G_, int c_) { nM = M / BM; nN = N / BM; nwg = nM * nN; G = G_; c = c_; }
    __host__ __device__ bool next(int i, Unit& u) const {
        const long L = (long)i * G + c; if (L >= nwg) return false;
        int wgid = (int)L; { const int q = nwg / NXCD, r = nwg % NXCD, xcd = wgid % NXCD, off = wgid / NXCD; wgid = (xcd < r ? xcd * (q + 1) : r * (q + 1) + (xcd - r) * q) + off; }
        const int nig = WGM * nN, gid = wgid / nig, fm = gid * WGM, gsz = (nM - fm) < WGM ? (nM - fm) : WGM;
        u.pm = fm + ((wgid % nig) % gsz); u.pn = (wgid % nig) / gsz; return true;
    }
    __device__ __forceinline__ void a_ready(const Unit&) const {}
    __device__ __forceinline__ void done(const Unit&) const {}
};
struct OneUnit {
    int pm, pn;
    __host__ __device__ bool next(int i, Unit& u) const { if (i != 0) return false; u.pm = pm; u.pn = pn; return true; }
    __device__ __forceinline__ void a_ready(const Unit&) const {}
    __device__ __forceinline__ void done(const Unit&) const {}
};
__device__ __forceinline__ unsigned cvt_pk_bf16(float lo, float hi) { unsigned r; asm volatile("v_cvt_pk_bf16_f32 %0, %1, %2" : "=v"(r) : "v"(lo), "v"(hi)); return r; }
template <class Epi, class Sched, bool ALIGN_EPI = false, bool SP2 = false>
__device__ __forceinline__ void gemm_phase(PG8_LAS unsigned char* lds, const Gemm g, const Sched& S, const Epi& E) {
    const int tid = tidx(), wid = __builtin_amdgcn_readfirstlane(tid >> 6), lane = tid & 63, wr = wid >> 2, wc = wid & 3, fr = lane & 15, fq = lane >> 4;
    const int K = g.K, nt = K / BK;
    unsigned voffA[2], voffB[2];
#pragma unroll
    for (int i = 0; i < 2; ++i) { int R, C; stage_rc(tid * 16 + i * 8192, R, C); const int Rb = Epi::PERM ? ((R & ~31) + perm32(R & 31)) : R;
        voffA[i] = (unsigned)(R * K + C) * 2u; voffB[i] = (unsigned)(Rb * K + C) * 2u; }
    const size_t kstep = (size_t)(BK * 2);
    const size_t hstep = (size_t)HALF * K * 2;
    const size_t tstep = 2 * hstep;
    const unsigned ldsw = (unsigned)wid * 1024u;
    const int aoff = lds_byte(wr * 64 + fr, fq * 8), boff = lds_byte(wc * 32 + fr, fq * 8);
#define PG8_SA(b, h) (((b) * 2 + (h)) * HTB)
#define PG8_SB(b, h) ((4 + (b) * 2 + (h)) * HTB)
#define PG8_STAGE(bufoff, gbase, voff) do { _Pragma("unroll") for (int _i = 0; _i < 2; ++_i) \
        __builtin_amdgcn_global_load_lds((const unsigned*)((const char*)(gbase) + (voff)[_i]), (PG8_LAS unsigned*)(lds + (bufoff) + ldsw + _i * 8192), 16, 0, 0); } while (0)
#define PG8_LDA(dst, b, h) do { _Pragma("unroll") for (int m = 0; m < 4; ++m) _Pragma("unroll") for (int k = 0; k < 2; ++k) dst[m][k] = *(const PG8_LAS bf16x8*)(lds + PG8_SA(b, h) + aoff + m * 2048 + k * 1024); } while (0)
#define PG8_LDB(dst, b, h) do { _Pragma("unroll") for (int n = 0; n < 2; ++n) _Pragma("unroll") for (int k = 0; k < 2; ++k) dst[n][k] = *(const PG8_LAS bf16x8*)(lds + PG8_SB(b, h) + boff + n * 2048 + k * 1024); } while (0)
#define PG8_MMA(ai, bj, At, Bt) do { __builtin_amdgcn_s_setprio(1); _Pragma("unroll") for (int m = 0; m < 4; ++m) _Pragma("unroll") for (int n = 0; n < 2; ++n) _Pragma("unroll") for (int k = 0; k < 2; ++k) \
        acc[ai][bj][m][n] = __builtin_amdgcn_mfma_f32_16x16x32_bf16(Bt[n][k], At[m][k], acc[ai][bj][m][n], 0, 0, 0); __builtin_amdgcn_s_setprio(0); } while (0)
#define PG8_WAIT_V(n) asm volatile("s_waitcnt vmcnt(" #n ")" ::: "memory")
#define PG8_WAIT_L(n) asm volatile("s_waitcnt lgkmcnt(" #n ")" ::: "memory")
#define PG8_BAR __builtin_amdgcn_s_barrier()
#define PG8_SCHED __builtin_amdgcn_sched_barrier(0)
    Unit cur, nxt; int ui = 0;
    if (!S.next(0, cur)) return;
    f32x4 acc[2][2][4][2];
#pragma unroll
    for (int a = 0; a < 2; ++a)
#pragma unroll
        for (int b = 0; b < 2; ++b)
#pragma unroll
            for (int m = 0; m < 4; ++m)
#pragma unroll
                for (int n = 0; n < 2; ++n) acc[a][b][m][n] = (f32x4){0.f, 0.f, 0.f, 0.f};
    bf16x8 At[4][2], B0[2][2], B1[2][2];
    const char* cA = (const char*)g.A + (size_t)cur.pm * tstep; const char* cB = (const char*)g.Bt + (size_t)cur.pn * tstep;
    S.a_ready(cur);
    if constexpr (SP2) {
        PG8_STAGE(PG8_SB(0, 0), cB, voffB); PG8_STAGE(PG8_SB(0, 1), cB + hstep, voffB); PG8_STAGE(PG8_SA(0, 0), cA, voffA); PG8_STAGE(PG8_SA(0, 1), cA + hstep, voffA);
        if (wr == 1) PG8_BAR;
        PG8_WAIT_V(2); PG8_BAR;
        PG8_STAGE(PG8_SB(1, 0), cB + kstep, voffB); PG8_STAGE(PG8_SA(1, 0), cA + kstep, voffA); PG8_STAGE(PG8_SB(1, 1), cB + hstep + kstep, voffB);
        PG8_WAIT_V(6); PG8_BAR;
    } else {
        PG8_STAGE(PG8_SB(0, 0), cB, voffB); PG8_STAGE(PG8_SA(0, 0), cA, voffA); PG8_STAGE(PG8_SB(0, 1), cB + hstep, voffB); PG8_STAGE(PG8_SA(0, 1), cA + hstep, voffA);
        if (wr == 1) PG8_BAR;
        PG8_WAIT_V(4); PG8_BAR;
        PG8_STAGE(PG8_SB(1, 0), cB + kstep, voffB); PG8_STAGE(PG8_SA(1, 0), cA + kstep, voffA); PG8_STAGE(PG8_SB(1, 1), cB + hstep + kstep, voffB);
        PG8_WAIT_V(6); PG8_BAR;
    }
    for (;;) {
        const bool has_next = S.next(ui + 1, nxt);
        const char* nA = has_next ? (const char*)g.A + (size_t)nxt.pm * tstep : cA; const char* nB = has_next ? (const char*)g.Bt + (size_t)nxt.pn * tstep : cB;
        for (int t = 0; t < nt; t += 2) {
            const bool last = (t == nt - 2);
            const char* a1 = cA + (size_t)(t + 1) * kstep;
            const char* a2 = last ? nA : cA + (size_t)(t + 2) * kstep; const char* b2 = last ? nB : cB + (size_t)(t + 2) * kstep;
            const char* a3 = a2 + kstep; const char* b3 = b2 + kstep;
            if (last && has_next) S.a_ready(nxt);
            if constexpr (SP2) {
            PG8_LDB(B0, 0, 0); PG8_LDB(B1, 0, 1); PG8_SCHED; PG8_LDA(At, 0, 0); PG8_STAGE(PG8_SA(1, 1), a1 + hstep, voffA);
            PG8_WAIT_V(8); PG8_WAIT_L(0); PG8_BAR; PG8_MMA(0, 0, At, B0); PG8_MMA(0, 1, At, B1); PG8_BAR; PG8_SCHED;
            PG8_LDA(At, 0, 1); PG8_STAGE(PG8_SB(0, 0), b2, voffB); PG8_STAGE(PG8_SB(0, 1), b2 + hstep, voffB); PG8_STAGE(PG8_SA(0, 0), a2, voffA);
            PG8_WAIT_V(8); PG8_WAIT_L(0); PG8_BAR; PG8_MMA(1, 0, At, B0); PG8_MMA(1, 1, At, B1); PG8_BAR; PG8_SCHED;
            PG8_LDB(B0, 1, 0); PG8_LDB(B1, 1, 1); PG8_SCHED; PG8_LDA(At, 1, 0); PG8_STAGE(PG8_SA(0, 1), a2 + hstep, voffA);
            PG8_WAIT_V(8); PG8_WAIT_L(0); PG8_BAR; PG8_MMA(0, 0, At, B0); PG8_MMA(0, 1, At, B1); PG8_BAR; PG8_SCHED;
            PG8_LDA(At, 1, 1); PG8_STAGE(PG8_SB(1, 0), b3, voffB); PG8_STAGE(PG8_SB(1, 1), b3 + hstep, voffB); PG8_STAGE(PG8_SA(1, 0), a3, voffA);
            PG8_WAIT_V(8); PG8_WAIT_L(0); PG8_BAR; PG8_MMA(1, 0, At, B0); PG8_MMA(1, 1, At, B1); PG8_BAR; PG8_SCHED;
            } else {
            PG8_LDB(B0, 0, 0); PG8_SCHED; PG8_LDA(At, 0, 0); PG8_STAGE(PG8_SA(1, 1), a1 + hstep, voffA);
            PG8_WAIT_L(8); PG8_BAR; PG8_WAIT_L(0); PG8_MMA(0, 0, At, B0); PG8_BAR; PG8_SCHED;
            PG8_LDB(B1, 0, 1); PG8_STAGE(PG8_SB(0, 0), b2, voffB);
            PG8_BAR; PG8_WAIT_L(0); PG8_MMA(0, 1, At, B1); PG8_BAR;
            PG8_LDA(At, 0, 1); PG8_STAGE(PG8_SA(0, 0), a2, voffA);
            PG8_BAR; PG8_WAIT_L(0); PG8_MMA(1, 0, At, B0); PG8_BAR; PG8_SCHED;
            PG8_STAGE(PG8_SB(0, 1), b2 + hstep, voffB);
            PG8_WAIT_V(6); PG8_BAR; PG8_MMA(1, 1, At, B1); PG8_BAR;
            PG8_LDB(B0, 1, 0); PG8_SCHED; PG8_LDA(At, 1, 0); PG8_STAGE(PG8_SA(0, 1), a2 + hstep, voffA);
            PG8_WAIT_L(8); PG8_BAR; PG8_WAIT_L(0); PG8_MMA(0, 0, At, B0); PG8_BAR; PG8_SCHED;
            PG8_LDB(B1, 1, 1); PG8_STAGE(PG8_SB(1, 0), b3, voffB);
            PG8_BAR; PG8_WAIT_L(0); PG8_MMA(0, 1, At, B1); PG8_BAR;
            PG8_LDA(At, 1, 1); PG8_STAGE(PG8_SA(1, 0), a3, voffA);
            PG8_BAR; PG8_WAIT_L(0); PG8_MMA(1, 0, At, B0); PG8_BAR; PG8_SCHED;
            PG8_STAGE(PG8_SB(1, 1), b3 + hstep, voffB);
            PG8_WAIT_V(6); PG8_BAR; PG8_MMA(1, 1, At, B1); PG8_BAR;
            }
        }
        if constexpr (ALIGN_EPI) { if (wr == 0) PG8_BAR; }
        if constexpr (!Epi::AFTER_DRAIN) { E(acc, cur, wr, wc, fr, fq); S.done(cur); }
        if (!has_next) break;
#pragma unroll
        for (int a = 0; a < 2; ++a)
#pragma unroll
            for (int b = 0; b < 2; ++b)
#pragma unroll
                for (int m = 0; m < 4; ++m)
#pragma unroll
                    for (int n = 0; n < 2; ++n) acc[a][b][m][n] = (f32x4){0.f, 0.f, 0.f, 0.f};
        cur = nxt; cA = nA; cB = nB; ++ui;
        if constexpr (ALIGN_EPI) { if (wr == 1) PG8_BAR; }
    }
    PG8_WAIT_V(0);
    if constexpr (!ALIGN_EPI) { if (wr == 0) PG8_BAR; }
    PG8_BAR;
    if constexpr (Epi::AFTER_DRAIN) { E.fused(acc, cur, wr, wc, fr, fq, lds, wid, lane); S.done(cur); }
#undef PG8_SA
#undef PG8_SB
#undef PG8_STAGE
#undef PG8_LDA
#undef PG8_LDB
#undef PG8_MMA
#undef PG8_WAIT_V
#undef PG8_WAIT_L
#undef PG8_BAR
#undef PG8_SCHED
}
}

struct EpiIn {
    static constexpr bool PERM = true, AFTER_DRAIN = false;
    unsigned char* ws;
    __device__ __forceinline__ void operator()(const pg8::f32x4 (&acc)[2][2][4][2], const pg8::Unit& u, int wr, int wc, int fr, int fq) const {
#pragma unroll
        for (int bj = 0; bj < 2; ++bj) {
            const int tn = u.pn * 2 + bj;
            if (tn >= 29) continue;
            bf16* dst; int pitch, coff; bool vt = false;
            if (tn < 6) { dst = (bf16*)(ws + WS_ZHY); pitch = 768; coff = tn * 128; }
            else if (tn < 8) { dst = (bf16*)(ws + WS_GATES); pitch = 1024; coff = (tn - 6) * 128; }
            else if (tn < 15) { dst = (bf16*)(ws + WS_ZRW); pitch = 896; coff = (tn - 8) * 128; }
            else if (tn < 17) { dst = (bf16*)(ws + WS_GATES); pitch = 1024; coff = 256 + (tn - 15) * 128; }
            else if (tn < 20) { dst = (bf16*)(ws + WS_ZWA); pitch = 384; coff = (tn - 17) * 128; }
            else if (tn == 20) { dst = (bf16*)(ws + WS_VTW); vt = true; pitch = 0; coff = 0; }
            else if (tn < 23) { dst = (bf16*)(ws + WS_GATES); pitch = 1024; coff = 512 + (tn - 21) * 128; }
            else if (tn < 26) { dst = (bf16*)(ws + WS_ZFA); pitch = 384; coff = (tn - 23) * 128; }
            else if (tn == 26) { dst = (bf16*)(ws + WS_VTF); vt = true; pitch = 0; coff = 0; }
            else { dst = (bf16*)(ws + WS_GATES); pitch = 1024; coff = 768 + (tn - 27) * 128; }
            const int cc = wc * 32 + 8 * fq;
#pragma unroll
            for (int ai = 0; ai < 2; ++ai)
#pragma unroll
                for (int m = 0; m < 4; ++m) {
                    const int row = u.pm * 256 + ai * 128 + wr * 64 + m * 16 + fr;
                    const pg8::f32x4 v0 = acc[ai][bj][m][0], v1 = acc[ai][bj][m][1];
                    if (!vt) {
                        u32x4 w; w.x = cvtpk_n(v0[0], v0[1]); w.y = cvtpk_n(v0[2], v0[3]); w.z = cvtpk_n(v1[0], v1[1]); w.w = cvtpk_n(v1[2], v1[3]);
                        *(u32x4*)(dst + (size_t)row * pitch + coff + cc) = w;
                    } else {
                        int bb, key;
                        if (row < MLAT) { bb = row / LAT; key = CTX + (row % LAT); } else { bb = (row - MLAT) / CTX; key = (row - MLAT) % CTX; }
                        bf16* o = dst + ((size_t)(bb * 2 + (cc >> 6)) * 64 + (cc & 63)) * SKV + key;
                        o[0 * SKV] = f2bf(v0[0]); o[1 * SKV] = f2bf(v0[1]); o[2 * SKV] = f2bf(v0[2]); o[3 * SKV] = f2bf(v0[3]);
                        o[4 * SKV] = f2bf(v1[0]); o[5 * SKV] = f2bf(v1[1]); o[6 * SKV] = f2bf(v1[2]); o[7 * SKV] = f2bf(v1[3]);
                    }
                }
        }
    }
};
template <bool CTXROWS>
struct EpiOutT {
    static constexpr bool PERM = false, AFTER_DRAIN = false;
    const bf16* xin_lat; const float* xin_ctx; bf16* out_lat; float* out_ctx; const float* gate;
    __device__ __forceinline__ void operator()(const pg8::f32x4 (&acc)[2][2][4][2], const pg8::Unit& u, int wr, int wc, int fr, int fq) const {
        const int row_t = u.pm * 256;
        const float* g = gate + (CTXROWS ? 8 : row_t / LAT) * 3072;
        pg8::f32x4 gg[2][2];
#pragma unroll
        for (int bj = 0; bj < 2; ++bj)
#pragma unroll
            for (int n = 0; n < 2; ++n) gg[bj][n] = *(const pg8::f32x4*)(g + u.pn * 256 + bj * 128 + wc * 32 + n * 16 + 4 * fq);
#pragma unroll
        for (int ai = 0; ai < 2; ++ai) {
            if constexpr (!CTXROWS) {
                u32x2 xr[4][2][2];
#pragma unroll
                for (int m = 0; m < 4; ++m) {
                    const int row = row_t + ai * 128 + wr * 64 + m * 16 + fr;
#pragma unroll
                    for (int bj = 0; bj < 2; ++bj)
#pragma unroll
                        for (int n = 0; n < 2; ++n) xr[m][bj][n] = *(const u32x2*)(xin_lat + (size_t)row * 1024 + u.pn * 256 + bj * 128 + wc * 32 + n * 16 + 4 * fq);
                }
                __builtin_amdgcn_sched_barrier(0);
#pragma unroll
                for (int m = 0; m < 4; ++m) {
                    const int row = row_t + ai * 128 + wr * 64 + m * 16 + fr;
#pragma unroll
                    for (int bj = 0; bj < 2; ++bj)
#pragma unroll
                        for (int n = 0; n < 2; ++n) {
                            const u32x2 r = xr[m][bj][n];
                            const pg8::f32x4 xn = (pg8::f32x4){bflo(r.x), bfhi(r.x), bflo(r.y), bfhi(r.y)} + gg[bj][n] * acc[ai][bj][m][n];
                            u32x2 w; w.x = pg8::cvt_pk_bf16(xn[0], xn[1]); w.y = pg8::cvt_pk_bf16(xn[2], xn[3]);
                            *(u32x2*)(out_lat + (size_t)row * 1024 + u.pn * 256 + bj * 128 + wc * 32 + n * 16 + 4 * fq) = w;
                        }
                }
            } else {
                pg8::f32x4 xv[4][2][2];
#pragma unroll
                for (int m = 0; m < 4; ++m) {
                    const int row = row_t + ai * 128 + wr * 64 + m * 16 + fr - MLAT;
#pragma unroll
                    for (int bj = 0; bj < 2; ++bj)
#pragma unroll
                        for (int n = 0; n < 2; ++n) xv[m][bj][n] = *(const pg8::f32x4*)(xin_ctx + (size_t)row * 1024 + u.pn * 256 + bj * 128 + wc * 32 + n * 16 + 4 * fq);
                }
                __builtin_amdgcn_sched_barrier(0);
#pragma unroll
                for (int m = 0; m < 4; ++m) {
                    const int row = row_t + ai * 128 + wr * 64 + m * 16 + fr - MLAT;
#pragma unroll
                    for (int bj = 0; bj < 2; ++bj)
#pragma unroll
                        for (int n = 0; n < 2; ++n) *(pg8::f32x4*)(out_ctx + (size_t)row * 1024 + u.pn * 256 + bj * 128 + wc * 32 + n * 16 + 4 * fq) = xv[m][bj][n] + gg[bj][n] * acc[ai][bj][m][n];
                }
            }
            __builtin_amdgcn_sched_barrier(0);
        }
    }
};

constexpr int LOWLD = 136;
__device__ __forceinline__ void ph_rw_prep(const P& p, int l, unsigned char* smem, int bid, int nblk) {
    const int tid = tidx(), lane = tid & 63, wave = __builtin_amdgcn_readfirstlane(tid >> 6), r = lane & 31, hh = lane >> 5;
    bf16* lowA = (bf16*)smem;
    const bf16* Z = (const bf16*)(p.ws + WS_ZRW);
    const float* cw = p.in[I_RWCONV] + (size_t)l * 3 * 896;
    bf16* RWb = (bf16*)(p.ws + WS_RW);
    const size_t AS = RW_STRIDE / 2;
    const int mtx = wave >> 1, nb = (wave & 1) * 128;
    const float* up = (mtx < 2 ? p.in[I_RWWUP] : p.in[I_RWAUP]) + (size_t)l * 2 * 64 * 256 + (size_t)(mtx & 1) * 64 * 256;
    bf16x8 Bf[4][4];
#pragma unroll
    for (int nt = 0; nt < 4; ++nt)
#pragma unroll
        for (int sI = 0; sI < 4; ++sI) {
            const float* u0 = up + (size_t)(16 * sI + 8 * hh) * 256 + nb + nt * 32 + r;
            u32x4 w; w.x = cvtpk_n(u0[0], u0[256]); w.y = cvtpk_n(u0[512], u0[768]); w.z = cvtpk_n(u0[1024], u0[1280]); w.w = cvtpk_n(u0[1536], u0[1792]);
            Bf[nt][sI] = __builtin_bit_cast(bf16x8, w);
        }
    const float* b0p = (mtx < 2 ? p.in[I_RWW0] : p.in[I_RWA0]) + l * 512 + (mtx & 1) * 256 + nb;
    float bias0[4];
#pragma unroll
    for (int nt = 0; nt < 4; ++nt) bias0[nt] = b0p[nt * 32 + r];
    const int c2 = tid * 2;
    float cwa[3][2];
#pragma unroll
    for (int d = 0; d < 3; ++d) { cwa[d][0] = tid < 448 ? cw[d * 896 + c2] : 0.f; cwa[d][1] = tid < 448 ? cw[d * 896 + c2 + 1] : 0.f; }
    unsigned zr[34];
    auto zload = [&](int tile) {
        const int row0 = tile * 32;
        int seq0, L;
        if (row0 < MLAT) { seq0 = (row0 / LAT) * LAT; L = LAT; } else { seq0 = MLAT + ((row0 - MLAT) / CTX) * CTX; L = CTX; }
        const int t0 = row0 - seq0;
#pragma unroll
        for (int i = 0; i < 34; ++i) { const int t = t0 - 1 + i; zr[i] = (t >= 0 && t < L && tid < 448) ? *(const unsigned*)(Z + (size_t)(row0 - 1 + i) * 896 + c2) : 0u; }
    };
    if (bid < MROWS / 32) zload(bid);
    for (int tile = bid; tile < MROWS / 32; tile += nblk) {
        const int row0 = tile * 32;
        if (tid < 448) {
            const int arr = c2 < 256 ? 0 : (c2 < 512 ? 2 : 1), cc = c2 & 255;
#pragma unroll
            for (int i = 0; i < 32; ++i) {
                const float o0 = bflo(zr[i]) * cwa[0][0] + bflo(zr[i + 1]) * cwa[1][0] + bflo(zr[i + 2]) * cwa[2][0];
                const float o1 = bfhi(zr[i]) * cwa[0][1] + bfhi(zr[i + 1]) * cwa[1][1] + bfhi(zr[i + 2]) * cwa[2][1];
                if (c2 < 768) *(unsigned*)(RWb + arr * AS + (size_t)(row0 + i) * 256 + cc) = cvtpk_n(o0, o1);
                else { const int c = c2 - 768; *(unsigned*)(lowA + i * LOWLD + c) = (c < 64) ? cvtpk_n(ftanh(o0), ftanh(o1)) : cvtpk_n(o0, o1); }
            }
        }
        if (tile + nblk < MROWS / 32) zload(tile + nblk);
        __syncthreads();
        f32x16 acc[4];
#pragma unroll
        for (int nt = 0; nt < 4; ++nt)
#pragma unroll
            for (int e = 0; e < 16; ++e) acc[nt][e] = 0.f;
#pragma unroll
        for (int sI = 0; sI < 4; ++sI) {
            const bf16x8 af = *(const bf16x8*)(lowA + r * LOWLD + (mtx < 2 ? 0 : 64) + sI * 16 + hh * 8);
#pragma unroll
            for (int nt = 0; nt < 4; ++nt) acc[nt] = __builtin_amdgcn_mfma_f32_32x32x16_bf16(af, Bf[nt][sI], acc[nt], 0, 0, 0);
        }
        bf16* dst = RWb + (size_t)((mtx < 2 ? 3 : 5) + (mtx & 1)) * AS;
        const float osc = mtx < 2 ? 0.6065306597126334f : 1.0f;
#pragma unroll
        for (int nt = 0; nt < 4; ++nt)
#pragma unroll
            for (int e = 0; e < 16; ++e) {
                const int tok = (e & 3) + 8 * (e >> 2) + 4 * hh;
                const float x = bias0[nt] + acc[nt][e];
                const float o = osc * __builtin_amdgcn_rcpf(1.0f + __expf(-x));
                dst[(size_t)(row0 + tok) * 256 + nb + nt * 32 + r] = (bf16)cvtpk_n(o, 0.f);
            }
        __syncthreads();
    }
}

__device__ __forceinline__ void ph_attn_prep(const P& p, int l, int bid, int nblk) {
    const float2* rope = (const float2*)(p.ws + WS_ROPE);
    const int tid = tidx();
    auto item_ptr = [&](int idx) -> bf16* { const int m = idx >> 5, sl = (idx >> 3) & 3, j8 = idx & 7;
        return (bf16*)(p.ws + (sl < 2 ? WS_ZWA : WS_ZFA)) + (size_t)m * 384 + 256 + (sl & 1) * 64 + j8 * 8; };
    const int idx0 = bid * NT + tid;
    u32x4 nraw = {0u, 0u, 0u, 0u};
    if (idx0 < MROWS * 32) nraw = *(const u32x4*)item_ptr(idx0);
    for (int idx = idx0; idx < MROWS * 32; idx += nblk * NT) {
        const int m = idx >> 5, sl = (idx >> 3) & 3, j8 = idx & 7, d0 = j8 * 8;
        bf16* ptr = item_ptr(idx);
        const u32x4 raw = nraw;
        if (idx + nblk * NT < MROWS * 32) nraw = *(const u32x4*)item_ptr(idx + nblk * NT);
        float x[8] = {bflo(raw.x), bfhi(raw.x), bflo(raw.y), bfhi(raw.y), bflo(raw.z), bfhi(raw.z), bflo(raw.w), bfhi(raw.w)};
        if (sl >= 2) {
            float ss = 0.f;
#pragma unroll
            for (int j = 0; j < 8; ++j) ss += x[j] * x[j];
            ss = sum8(ss);
            const float rs = rsqrtf(ss * (1.0f / 64.0f) + 1e-6f);
            const float* g = p.in[I_FAKN] + l * 64 + d0;
#pragma unroll
            for (int j = 0; j < 8; ++j) x[j] = x[j] * rs * g[j];
        }
        if (m < MLAT) {
            const int pos = m % LAT;
            const float2* cs = rope + pos * 32 + (j8 >> 2) * 16 + (j8 & 1) * 8;
            const bool up = (j8 & 2) != 0;
#pragma unroll
            for (int j = 0; j < 8; ++j) {
                const float other = __int_as_float(__builtin_amdgcn_update_dpp(0, __float_as_int(x[j]), 0x4E, 0xF, 0xF, true));
                const float2 c = cs[j];
                x[j] = up ? (x[j] * c.x + other * c.y) : (x[j] * c.x - other * c.y);
            }
        }
        u32x4 o; o.x = cvtpk_n(x[0], x[1]); o.y = cvtpk_n(x[2], x[3]); o.z = cvtpk_n(x[4], x[5]); o.w = cvtpk_n(x[6], x[7]);
        *(u32x4*)ptr = o;
    }
}

constexpr int TC = 32;
typedef float f32x2 __attribute__((ext_vector_type(2)));
__device__ __forceinline__ float sum16(float x) {
    x += __int_as_float(__builtin_amdgcn_update_dpp(0, __float_as_int(x), 0xB1, 0xF, 0xF, true));
    x += __int_as_float(__builtin_amdgcn_update_dpp(0, __float_as_int(x), 0x4E, 0xF, 0xF, true));
    x += __int_as_float(__builtin_amdgcn_update_dpp(0, __float_as_int(x), 0x141, 0xF, 0xF, true));
    x += __int_as_float(__builtin_amdgcn_update_dpp(0, __float_as_int(x), 0x140, 0xF, 0xF, true));
    return x;
}
constexpr int SCAN_STEP_F = 320 + 64;
constexpr int SCAN_BUF_F = TC * SCAN_STEP_F;
__device__ __forceinline__ void rw_scan_chain(const P& p, int l, int item, unsigned char* smem) {
    float* bufs = (float*)smem; float* sys = bufs + 2 * SCAN_BUF_F;
    const int tid = tidx(), lane = tid & 63, wave = tid >> 6;
    const int chain = item >> 1, half = item & 1;
    const bf16* RWb = (const bf16*)(p.ws + WS_RW); const size_t AS = RW_STRIDE / 2;
    const int dir = chain & 1, h = (chain >> 1) & 3, b = chain >> 3;
    bf16* Y = (bf16*)(p.ws + (dir == 0 ? WS_YF : WS_YB));
    const int NCH = (CTX + LAT) / TC;
    auto tok_row = [&](int g) -> int {
        if (g < CTX) { int t = dir == 0 ? g : (CTX - 1 - g); return row_ctx(b, t); }
        int t = dir == 0 ? (g - CTX) : (LAT - 1 - (g - CTX)); return row_lat(b, t);
    };
    const bool producer = wave >= 4;
    const float kkw = p.in[I_RWKK][l * 256 + h * 64 + lane], kaw = p.in[I_RWKA][l * 256 + h * 64 + lane];
    auto stage = [&](int c) {
        float* buf = bufs + (c & 1) * SCAN_BUF_F;
        const int pw = wave - 4;
        bf16 gr[8], gv[8], gk[8], ge[8], ga[8];
#pragma unroll
        for (int i = 0; i < 8; ++i) {
            size_t o = (size_t)tok_row(c * TC + i * 4 + pw) * 256 + h * 64 + lane;
            gr[i] = RWb[0 * AS + o]; gv[i] = RWb[1 * AS + o]; gk[i] = RWb[2 * AS + o]; ge[i] = RWb[(3 + dir) * AS + o]; ga[i] = RWb[(5 + dir) * AS + o];
        }
#pragma unroll
        for (int i = 0; i < 8; ++i) {
            const int s = i * 4 + pw;
            float rv = bf2f(gr[i]), vv = bf2f(gv[i]), kv = bf2f(gk[i]), e = bf2f(ge[i]), a = bf2f(ga[i]);
            float kq = kv * kkw;
            const int q16 = __float_as_int(sum16(kq * kq));
            const float n2 = (__int_as_float(__builtin_amdgcn_readlane(q16, 0)) + __int_as_float(__builtin_amdgcn_readlane(q16, 16))) +
                             (__int_as_float(__builtin_amdgcn_readlane(q16, 32)) + __int_as_float(__builtin_amdgcn_readlane(q16, 48)));
            float kk = kq / fmaxf(sqrtf(n2), 1e-12f);
            float* d = buf + s * SCAN_STEP_F + (lane >> 2) * 20 + (lane & 3);
            d[0] = -kk; d[4] = __expf(-e); d[8] = kk * a; d[12] = kv * (1.0f + (a - 1.0f) * kaw); d[16] = rv;
            buf[s * SCAN_STEP_F + 320 + lane] = vv;
        }
    };
    auto ystore = [&](int c) {
        const float* sy = sys + (c & 1) * (TC * 32);
        const int pw = wave - 4;
#pragma unroll
        for (int i = 0; i < 4; ++i) { const int s = i * 8 + pw * 2 + (lane >> 5); Y[(size_t)tok_row(c * TC + s) * 256 + h * 64 + half * 32 + (lane & 31)] = f2bf(sy[s * 32 + (lane & 31)]); }
    };
    const int rp = tid >> 4, part = tid & 15;
    f32x2 Sa0 = (f32x2){0.f, 0.f}, Sa1 = Sa0, Sb0 = Sa0, Sb1 = Sa0;
    __syncthreads();
    if (producer) stage(0);
    __syncthreads();
    for (int c = 0; c < NCH; ++c) {
        if (producer) {
            if (c > 0) ystore(c - 1);
            if (c + 1 < NCH) stage(c + 1);
        } else {
            const float* buf = bufs + (c & 1) * SCAN_BUF_F; float* sy = sys + (c & 1) * (TC * 32);
            const float* bp0 = buf + part * 20; const float* vp0 = buf + 320 + half * 32 + 2 * rp;
            f32x4 k4 = *(const f32x4*)(bp0), w4 = *(const f32x4*)(bp0 + 4), b4 = *(const f32x4*)(bp0 + 8), d4 = *(const f32x4*)(bp0 + 12), r4 = *(const f32x4*)(bp0 + 16);
            f32x2 vv = *(const f32x2*)(vp0);
#pragma unroll
            for (int s16 = 0; s16 < TC / 16; ++s16) {
                float ykeepa = 0.f, ykeepb = 0.f;
#pragma unroll
                for (int s1 = 0; s1 < 16; ++s1) {
                    const int s = s16 * 16 + s1;
                    const int sn = (s + 1 < TC) ? s + 1 : s;
                    const float* bn = bp0 + sn * SCAN_STEP_F;
                    const f32x4 nk4 = *(const f32x4*)(bn), nw4 = *(const f32x4*)(bn + 4), nb4 = *(const f32x4*)(bn + 8), nd4 = *(const f32x4*)(bn + 12), nr4 = *(const f32x4*)(bn + 16);
                    const f32x2 nvv = *(const f32x2*)(vp0 + sn * SCAN_STEP_F);
                    const f32x2 kl = (f32x2){k4.x, k4.y}, kh = (f32x2){k4.z, k4.w};
                    const f32x2 pa = Sa0 * kl + Sa1 * kh, pb = Sb0 * kl + Sb1 * kh;
                    const float saa = sum16(pa.x + pa.y), sab = sum16(pb.x + pb.y);
                    const f32x2 wl = (f32x2){w4.x, w4.y}, wh = (f32x2){w4.z, w4.w}, bl = (f32x2){b4.x, b4.y}, bh = (f32x2){b4.z, b4.w}, dl = (f32x2){d4.x, d4.y}, dh = (f32x2){d4.z, d4.w};
                    const f32x2 sa2 = (f32x2){saa, saa}, sb2 = (f32x2){sab, sab}, va2 = (f32x2){vv.x, vv.x}, vb2 = (f32x2){vv.y, vv.y};
                    Sa0 = Sa0 * wl + (sa2 * bl + va2 * dl); Sa1 = Sa1 * wh + (sa2 * bh + va2 * dh);
                    Sb0 = Sb0 * wl + (sb2 * bl + vb2 * dl); Sb1 = Sb1 * wh + (sb2 * bh + vb2 * dh);
                    const f32x2 rl = (f32x2){r4.x, r4.y}, rh = (f32x2){r4.z, r4.w};
                    const f32x2 qa = Sa0 * rl + Sa1 * rh, qb = Sb0 * rl + Sb1 * rh;
                    const float ya = sum16(qa.x + qa.y), yb = sum16(qb.x + qb.y);
                    ykeepa = (part == s1) ? ya : ykeepa; ykeepb = (part == s1) ? yb : ykeepb;
                    k4 = nk4; w4 = nw4; b4 = nb4; d4 = nd4; r4 = nr4; vv = nvv;
                }
                *(f32x2*)(sy + (s16 * 16 + part) * 32 + 2 * rp) = (f32x2){ykeepa, ykeepb};
            }
        }
        __syncthreads();
    }
    if (producer) ystore(NCH - 1);
    __syncthreads();
}

typedef float f32x4v __attribute__((ext_vector_type(4)));
constexpr int CK_NRP = 72, CK_ZVP = 40, CK_WP = 24, CK_TP = 24, CK_AKP = 40, CK_SBP = 72, CK_BHP = 40;
constexpr int CK_NR = 0;
constexpr int CK_BK = CK_NR + 2 * 32 * CK_NRP * 2;
constexpr int CK_BH = CK_BK + 32 * CK_NRP * 2;
constexpr int CK_ZV = CK_BH + 2 * 64 * CK_BHP * 2;
constexpr int CK_WB = CK_ZV + 2 * 64 * CK_ZVP * 2;
constexpr int CK_TT = CK_WB + 64 * CK_WP * 2;
constexpr int CK_BKT = CK_TT + 2 * 16 * CK_TP * 2;
constexpr int CK_AK = CK_BKT + 2 * 16 * CK_TP * 2;
constexpr int CK_SB = CK_AK + 2 * 16 * CK_AKP * 2;
constexpr int CK_AM = CK_SB + 64 * CK_SBP * 2;
constexpr int CK_P15 = CK_AM + 16 * 16 * 4;
constexpr int CK_SY = CK_P15 + 2 * 64 * 4;
constexpr int CK_PM = CK_SY + 2 * 16 * 64 * 4;
constexpr int CK_END = CK_PM + 17 * 64 * 4;
static_assert(CK_END <= LDS_BYTES - 64, "chunked scan LDS");
__device__ __forceinline__ void rw_scan_chunked(const P& p, int l, int chain, unsigned char* smem) {
    const int tid = tidx(), lane = tid & 63, wave = __builtin_amdgcn_readfirstlane(tid >> 6), lr = lane & 15, lg = lane >> 4;
    const bf16* RWb = (const bf16*)(p.ws + WS_RW); const size_t AS = RW_STRIDE / 2;
    const int dir = chain & 1, h = (chain >> 1) & 3, b = chain >> 3;
    bf16* Yout = (bf16*)(p.ws + (dir == 0 ? WS_YF : WS_YB));
    constexpr int CC = 16, NCH = (CTX + LAT) / CC;
    auto lowrow = [&](int c) -> int {
        const int g0 = c * CC;
        if (g0 < CTX) return row_ctx(b, dir == 0 ? g0 : (CTX - CC - g0));
        return row_lat(b, dir == 0 ? (g0 - CTX) : (LAT - CC - (g0 - CTX)));
    };
    bf16* NR = (bf16*)(smem + CK_NR); bf16* BK = (bf16*)(smem + CK_BK); bf16* BH = (bf16*)(smem + CK_BH); bf16* ZV = (bf16*)(smem + CK_ZV);
    bf16* WB = (bf16*)(smem + CK_WB); bf16* TT = (bf16*)(smem + CK_TT); bf16* BKT = (bf16*)(smem + CK_BKT); bf16* AK = (bf16*)(smem + CK_AK);
    bf16* SB = (bf16*)(smem + CK_SB); float* AMT = (float*)(smem + CK_AM); float* P15 = (float*)(smem + CK_P15);
    float* SY = (float*)(smem + CK_SY);
    const bool isY = wave >= 4; const int wx = wave & 3;
    const float kkw = p.in[I_RWKK][l * 256 + h * 64 + lane], kaw = p.in[I_RWKA][l * 256 + h * 64 + lane];
    const bf16x8 zero8 = {0, 0, 0, 0, 0, 0, 0, 0};
    for (int i = tid; i < 64 * CK_SBP / 2; i += NT) ((unsigned*)SB)[i] = 0u;
    for (int i = tid; i < 2 * 64 * CK_ZVP / 2; i += NT) ((unsigned*)ZV)[i] = 0u;
    f32x4v Sacc[4];
#pragma unroll
    for (int n = 0; n < 4; ++n) Sacc[n] = (f32x4v){0.f, 0.f, 0.f, 0.f};
    struct Raw { u32x2 qr, qv, qk, qa; };
    Raw rawA, rawB;
    const int pst = 4 * (wave & 3) + (lane >> 4), pj = dir ? 15 - pst : pst, k0 = 4 * (lane & 15);
    float kkw4[4], kaw4[4];
#pragma unroll
    for (int i = 0; i < 4; ++i) { kkw4[i] = p.in[I_RWKK][l * 256 + h * 64 + k0 + i]; kaw4[i] = p.in[I_RWKA][l * 256 + h * 64 + k0 + i]; }
    float* PM = (float*)(smem + CK_PM);
    bf16 ge[16];
    auto eload = [&](int c) {
        const bf16* ep = RWb + (3 + dir) * AS + (size_t)lowrow(c) * 256 + h * 64 + lane;
#pragma unroll
        for (int j = 0; j < 16; ++j) ge[j] = ep[j * 256];
    };
    auto etable = [&]() {
        float pm = 0.f;
#pragma unroll
        for (int j = 0; j < 16; ++j) { pm += bf2f(ge[j]) * 1.4426950408889634f; PM[(j + 1) * 64 + lane] = pm; }
    };
    auto yload = [&](int c, Raw& R) {
        const size_t o = (size_t)(lowrow(c) + pj) * 256 + h * 64 + k0;
        R.qr = *(const u32x2*)(RWb + 0 * AS + o); R.qv = *(const u32x2*)(RWb + 1 * AS + o); R.qk = *(const u32x2*)(RWb + 2 * AS + o); R.qa = *(const u32x2*)(RWb + (5 + dir) * AS + o);
    };
    if (wave == 7) { PM[lane] = 0.f; eload(0); etable(); eload(1); }
    if (!isY) { yload(0, rawA); yload(1, rawB); }
    __syncthreads();
    auto period = [&](const int pp, Raw& R) {
        const int cb = pp & 1, nb = (pp + 1) & 1;
        const bool prep = (pp + 1 < NCH), xwork = !isY && (pp >= 0);
        if (prep && !isY) {
            const float* pmw = PM + k0;
            const f32x4v c15 = *(const f32x4v*)(pmw + 16 * 64), s0 = *(const f32x4v*)(pmw + pj * 64), s1 = *(const f32x4v*)(pmw + (pj + 1) * 64);
            const float rv[4] = {bflo(R.qr.x), bfhi(R.qr.x), bflo(R.qr.y), bfhi(R.qr.y)}, vv[4] = {bflo(R.qv.x), bfhi(R.qv.x), bflo(R.qv.y), bfhi(R.qv.y)};
            const float kv[4] = {bflo(R.qk.x), bfhi(R.qk.x), bflo(R.qk.y), bfhi(R.qk.y)}, av[4] = {bflo(R.qa.x), bfhi(R.qa.x), bflo(R.qa.y), bfhi(R.qa.y)};
            float kq[4], n2p = 0.f;
#pragma unroll
            for (int i = 0; i < 4; ++i) { kq[i] = kv[i] * kkw4[i]; n2p += kq[i] * kq[i]; }
            const float rs = __builtin_amdgcn_rsqf(fmaxf(sum16(n2p), 1e-24f));
            float nr0[4], nr1[4], bk0[4], bk1[4], bh[4], kh[4];
#pragma unroll
            for (int i = 0; i < 4; ++i) {
                const float kk = kq[i] * rs, bbv = kk * av[i], kdv = kv[i] * (1.0f + (av[i] - 1.0f) * kaw4[i]);
                const float et = s1[i] - s0[i], cst = dir ? c15[i] - s0[i] : s1[i];
                const float Pt = __builtin_amdgcn_exp2f(-cst), Pm1 = __builtin_amdgcn_exp2f(et - cst), Pinv = __builtin_amdgcn_exp2f(cst), Ph = __builtin_amdgcn_exp2f(cst - c15[i]);
                nr0[i] = -kk * Pm1; nr1[i] = rv[i] * Pt; bk0[i] = bbv * Pinv; bk1[i] = kdv * Pinv; bh[i] = bbv * Ph; kh[i] = kdv * Ph;
            }
            { u32x2 w; w.x = cvtpk_n(nr0[0], nr0[1]); w.y = cvtpk_n(nr0[2], nr0[3]); *(u32x2*)(NR + (nb * 32 + pst) * CK_NRP + k0) = w; }
            { u32x2 w; w.x = cvtpk_n(nr1[0], nr1[1]); w.y = cvtpk_n(nr1[2], nr1[3]); *(u32x2*)(NR + (nb * 32 + 16 + pst) * CK_NRP + k0) = w; }
            { u32x2 w; w.x = cvtpk_n(bk0[0], bk0[1]); w.y = cvtpk_n(bk0[2], bk0[3]); *(u32x2*)(BK + pst * CK_NRP + k0) = w; }
            { u32x2 w; w.x = cvtpk_n(bk1[0], bk1[1]); w.y = cvtpk_n(bk1[2], bk1[3]); *(u32x2*)(BK + (16 + pst) * CK_NRP + k0) = w; }
#pragma unroll
            for (int i = 0; i < 4; ++i) {
                BH[(nb * 64 + k0 + i) * CK_BHP + pst] = cvt1(bh[i]); BH[(nb * 64 + k0 + i) * CK_BHP + 16 + pst] = cvt1(kh[i]);
                ZV[(nb * 64 + k0 + i) * CK_ZVP + 16 + pst] = cvt1(vv[i]);
            }
            if (wave == 0 && lane < 16) { f32x4v e;
#pragma unroll
                for (int i = 0; i < 4; ++i) e[i] = __builtin_amdgcn_exp2f(-c15[i]);
                *(f32x4v*)(P15 + nb * 64 + k0) = e; }
        }
        if (isY && pp >= 1) {
            const float* sy = SY + ((pp - 1) & 1) * 1024;
#pragma unroll
            for (int i = 0; i < 4; ++i) { const int idx = (tid - 256) + 256 * i, t = idx >> 6, v = idx & 63; Yout[(size_t)(lowrow(pp - 1) + (dir ? 15 - t : t)) * 256 + h * 64 + v] = cvt1(sy[t * 64 + v]); }
        }
        __syncthreads();
        if (!isY && pp + 3 < NCH) yload(pp + 3, R);
        if (isY) {
            if (prep) {
                if (wave == 7 && pp + 2 < NCH) { etable(); if (pp + 3 < NCH) eload(pp + 3); }
                const int mi = wx >> 1, ni = wx & 1;
                f32x4v acc = (f32x4v){0.f, 0.f, 0.f, 0.f};
#pragma unroll
                for (int ks = 0; ks < 2; ++ks)
                    acc = __builtin_amdgcn_mfma_f32_16x16x32_bf16(*(const bf16x8*)(BK + (16 * mi + lr) * CK_NRP + 32 * ks + 8 * lg),
                                                                  *(const bf16x8*)(NR + (nb * 32 + 16 * ni + lr) * CK_NRP + 32 * ks + 8 * lg), acc, 0, 0, 0);
                f32x4v o;
#pragma unroll
                for (int rg = 0; rg < 4; ++rg) { const int i = 4 * lg + rg; o[rg] = (ni == 0 ? (i < lr) : (i <= lr)) ? acc[rg] : 0.f; }
                if (wave != 4) {
                    bf16* dst = (ni == 0) ? (BKT + (nb * 16 + lr) * CK_TP + 4 * lg) : (AK + (nb * 16 + lr) * CK_AKP + 16 * mi + 4 * lg);
                    u32x2 w; w.x = cvtpk_n(o[0], o[1]); w.y = cvtpk_n(o[2], o[3]);
                    *(u32x2*)dst = w;
                } else {
                    *(f32x4v*)(AMT + lr * 16 + 4 * lg) = o;
                    asm volatile("s_waitcnt lgkmcnt(0)" ::: "memory");
                    const int r = lane >> 2, cq = lane & 3;
                    f32x4v arow[16];
#pragma unroll
                    for (int t = 0; t < 16; ++t) arow[t] = *(const f32x4v*)(AMT + t * 16 + 4 * cq);
                    float Tq[4];
#pragma unroll
                    for (int j = 0; j < 4; ++j) Tq[j] = (r == 4 * cq + j) ? 1.0f : 0.0f;
                    int cqv = cq; asm volatile("" : "+v"(cqv));
#pragma unroll
                    for (int t = 1; t < 16; ++t) {
                        float part = Tq[0] * arow[t][0] + Tq[1] * arow[t][1] + Tq[2] * arow[t][2] + Tq[3] * arow[t][3];
                        part += __int_as_float(__builtin_amdgcn_update_dpp(0, __float_as_int(part), 0xB1, 0xF, 0xF, true));
                        part += __int_as_float(__builtin_amdgcn_update_dpp(0, __float_as_int(part), 0x4E, 0xF, 0xF, true));
                        Tq[t & 3] = (cqv == (t >> 2)) ? Tq[t & 3] + part : Tq[t & 3];
                    }
#pragma unroll
                    for (int j = 0; j < 4; ++j) TT[(nb * 16 + 4 * cq + j) * CK_TP + r] = (bf16)cvtpk_n(Tq[j], 0.f);
                }
            }
        } else if (xwork) {
            {
                f32x4v accN = (f32x4v){0.f, 0.f, 0.f, 0.f}, accR = accN;
#pragma unroll
                for (int ks = 0; ks < 2; ++ks) {
                    const bf16x8 a = *(const bf16x8*)(SB + (16 * wx + lr) * CK_SBP + 32 * ks + 8 * lg);
                    const bf16x8 bN = *(const bf16x8*)(NR + (cb * 32 + lr) * CK_NRP + 32 * ks + 8 * lg);
                    const bf16x8 bR = *(const bf16x8*)(NR + (cb * 32 + 16 + lr) * CK_NRP + 32 * ks + 8 * lg);
                    accN = __builtin_amdgcn_mfma_f32_16x16x32_bf16(a, bN, accN, 0, 0, 0);
                    accR = __builtin_amdgcn_mfma_f32_16x16x32_bf16(a, bR, accR, 0, 0, 0);
                }
                {
                    const bf16x8 a = (lg < 2) ? *(const bf16x8*)(ZV + (cb * 64 + 16 * wx + lr) * CK_ZVP + 16 + 8 * lg) : zero8;
                    const bf16x8 bq = (lg < 2) ? *(const bf16x8*)(BKT + (cb * 16 + lr) * CK_TP + 8 * lg) : zero8;
                    accN = __builtin_amdgcn_mfma_f32_16x16x32_bf16(a, bq, accN, 0, 0, 0);
                }
#pragma unroll
                for (int rg = 0; rg < 4; ++rg) WB[(16 * wx + 4 * lg + rg) * CK_WP + lr] = cvt1(accN[rg]);
                asm volatile("s_waitcnt lgkmcnt(0)" ::: "memory");
                const bf16x8 aw = (lg < 2) ? *(const bf16x8*)(WB + (16 * wx + lr) * CK_WP + 8 * lg) : zero8;
                const bf16x8 bt = (lg < 2) ? *(const bf16x8*)(TT + (cb * 16 + lr) * CK_TP + 8 * lg) : zero8;
                const f32x4v accZ = __builtin_amdgcn_mfma_f32_16x16x32_bf16(aw, bt, (f32x4v){0.f, 0.f, 0.f, 0.f}, 0, 0, 0);
#pragma unroll
                for (int rg = 0; rg < 4; ++rg) ZV[(cb * 64 + 16 * wx + 4 * lg + rg) * CK_ZVP + lr] = cvt1(accZ[rg]);
                asm volatile("s_waitcnt lgkmcnt(0)" ::: "memory");
                const bf16x8 a = *(const bf16x8*)(ZV + (cb * 64 + 16 * wx + lr) * CK_ZVP + 8 * lg);
                const f32x4v accY = __builtin_amdgcn_mfma_f32_16x16x32_bf16(a, *(const bf16x8*)(AK + (cb * 16 + lr) * CK_AKP + 8 * lg), accR, 0, 0, 0);
                *(f32x4v*)(SY + cb * 1024 + lr * 64 + 16 * wx + 4 * lg) = accY;
#pragma unroll
                for (int n = 0; n < 4; ++n) {
                    const float pc = P15[cb * 64 + 16 * n + lr];
                    Sacc[n] = Sacc[n] * pc;
                    Sacc[n] = __builtin_amdgcn_mfma_f32_16x16x32_bf16(a, *(const bf16x8*)(BH + (cb * 64 + 16 * n + lr) * CK_BHP + 8 * lg), Sacc[n], 0, 0, 0);
#pragma unroll
                    for (int rg = 0; rg < 4; ++rg) SB[(16 * wx + 4 * lg + rg) * CK_SBP + 16 * n + lr] = cvt1(Sacc[n][rg]);
                }
            }
        }
        __syncthreads();
    };
    for (int pp = -1; pp < NCH; pp += 2) { period(pp, rawA); if (pp + 1 < NCH) period(pp + 1, rawB); }
    if (!isY) {
        const float* sy = SY + ((NCH - 1) & 1) * 1024;
#pragma unroll
        for (int i = 0; i < 4; ++i) { const int idx = tid + 256 * i, t = idx >> 6, v = idx & 63; Yout[(size_t)(lowrow(NCH - 1) + (dir ? 15 - t : t)) * 256 + h * 64 + v] = (bf16)cvtpk_n(sy[t * 64 + v], 0.f); }
    }
    __syncthreads();
}

__device__ __forceinline__ void ph_rw_readout(const P& p, int l, int row_lo, int row_hi, int bid, int nblk) {
    const int tid = tidx();
    const bf16* RWb = (const bf16*)(p.ws + WS_RW); const size_t AS = RW_STRIDE / 2;
    const bf16* YF = (const bf16*)(p.ws + WS_YF); const bf16* YB = (const bf16*)(p.ws + WS_YB);
    const bf16* G = (const bf16*)(p.ws + WS_GATES); bf16* MIX = (bf16*)(p.ws + WS_MIX);
    const int c0 = (tid & 31) * 8;
    float kaw[8], rk[8], lg[8], lb[8];
#pragma unroll
    for (int j = 0; j < 8; ++j) { kaw[j] = p.in[I_RWKA][l * 256 + c0 + j]; rk[j] = p.in[I_RWRK][l * 256 + c0 + j]; lg[j] = p.in[I_RWLNG][l * 256 + c0 + j]; lb[j] = p.in[I_RWLNB][l * 256 + c0 + j]; }
    u32x4 nyf, nyb, nrr, nvv, nkk, naf, nab, ngg;
    auto rload = [&](int idx) { const int m = idx >> 5; const size_t o = (size_t)m * 256 + c0;
        nyf = *(const u32x4*)(YF + o); nyb = *(const u32x4*)(YB + o); nrr = *(const u32x4*)(RWb + 0 * AS + o); nvv = *(const u32x4*)(RWb + 1 * AS + o);
        nkk = *(const u32x4*)(RWb + 2 * AS + o); naf = *(const u32x4*)(RWb + 5 * AS + o); nab = *(const u32x4*)(RWb + 6 * AS + o); ngg = *(const u32x4*)(G + (size_t)m * 1024 + 256 + c0); };
    { const int i0 = row_lo * 32 + bid * NT + tid; if (i0 < row_hi * 32) rload(i0); }
    for (int idx = row_lo * 32 + bid * NT + tid; idx < row_hi * 32; idx += nblk * NT) {
        const int m = idx >> 5;
        u32x4 outw;
#if EN_B
        const u32x4 yf = nyf, yb = nyb, rr = nrr, vv = nvv, kk = nkk, af = naf, ab = nab, gg = ngg;
        if (idx + nblk * NT < row_hi * 32) rload(idx + nblk * NT);
        float y[8], rv[8], v8[8], kv[8], a8[8], g8[8];
#pragma unroll
        for (int q = 0; q < 4; ++q) {
            y[2 * q] = bflo(yf[q]) + bflo(yb[q]); y[2 * q + 1] = bfhi(yf[q]) + bfhi(yb[q]);
            rv[2 * q] = bflo(rr[q]); rv[2 * q + 1] = bfhi(rr[q]); v8[2 * q] = bflo(vv[q]); v8[2 * q + 1] = bfhi(vv[q]);
            kv[2 * q] = bflo(kk[q]); kv[2 * q + 1] = bfhi(kk[q]); a8[2 * q] = bflo(af[q]) + bflo(ab[q]); a8[2 * q + 1] = bfhi(af[q]) + bfhi(ab[q]);
            g8[2 * q] = bflo(gg[q]); g8[2 * q + 1] = bfhi(gg[q]);
        }
        float s1 = 0.f, bn = 0.f;
#pragma unroll
        for (int j = 0; j < 8; ++j) { s1 += y[j]; bn += rv[j] * kv[j] * (2.0f + (a8[j] - 2.0f) * kaw[j]) * rk[j]; }
        s1 = sum8(s1); bn = sum8(bn);
        const float mu = s1 * (1.0f / 64.0f);
        float s2 = 0.f;
#pragma unroll
        for (int j = 0; j < 8; ++j) { y[j] -= mu; s2 += y[j] * y[j]; }
        s2 = sum8(s2);
        const float rs = rsqrtf(s2 * (1.0f / 64.0f) + 64e-5f);
        float ov[8];
#pragma unroll
        for (int j = 0; j < 8; ++j) ov[j] = (y[j] * rs * lg[j] + lb[j] + bn * v8[j]) * siluf(g8[j]);
        outw.x = cvtpk_n(ov[0], ov[1]); outw.y = cvtpk_n(ov[2], ov[3]); outw.z = cvtpk_n(ov[4], ov[5]); outw.w = cvtpk_n(ov[6], ov[7]);
#else
        outw.x = 0; outw.y = 0; outw.z = 0; outw.w = 0;
#endif
        *(u32x4*)(MIX + (size_t)m * 1024 + 256 + c0) = outw;
    }
}

constexpr int HPT = 72;
__device__ __forceinline__ void ph_hy_prep(const P& p, int l, unsigned char* smem, int bid, int nblk) {
    constexpr int TP = 66, NSEQ = 8 * (LAT / 128) + 8 * (CTX / 128);
    bf16* tiles = (bf16*)smem;
    const int tid = tidx();
    const bf16* Z = (const bf16*)(p.ws + WS_ZHY); const bf16* G = (const bf16*)(p.ws + WS_GATES); bf16* HT = (bf16*)(p.ws + WS_HMIX);
    const float* cw = p.in[I_HYCONV] + (size_t)l * 3 * 768;
    const int rr = tid >> 3, ch = tid & 7;
    const int nst = (nblk >= 16) ? (nblk >> 4) : 1;
    const int ct = bid & 15, kind = ct >> 2, c0 = (ct & 3) * 64;
    float w0[8], w1[8], w2[8];
#pragma unroll
    for (int j = 0; j < 8; ++j) { const int col = (kind < 3 ? kind : 0) * 256 + c0 + ch * 8 + j; w0[j] = cw[col]; w1[j] = cw[768 + col]; w2[j] = cw[1536 + col]; }
    u32x4 rcm = {0u, 0u, 0u, 0u}, rc0 = rcm, rc1 = rcm, rc2 = rcm;
    auto seq = [&](int st, int& b, int& t0, int& L, int& row0, size_t& obase) {
        if (st < 8 * (LAT / 128)) { b = st / (LAT / 128); t0 = (st % (LAT / 128)) * 128; L = LAT; row0 = row_lat(b, 0); obase = (size_t)b * 4 * 256 * LAT; }
        else { const int s2 = st - 8 * (LAT / 128); b = s2 / (CTX / 128); t0 = (s2 % (CTX / 128)) * 128; L = CTX; row0 = row_ctx(b, 0); obase = HYT_CTX_OFF + (size_t)b * 4 * 256 * CTX; }
    };
    auto tload = [&](int st) {
        int b, t0, L, row0; size_t obase; seq(st, b, t0, L, row0, obase);
        const int t = t0 + 2 * rr;
        rcm = (u32x4){0u, 0u, 0u, 0u}; rc2 = rcm;
        if (kind < 3) {
            const bf16* zp = Z + (size_t)(row0 + t) * 768 + kind * 256 + c0 + ch * 8;
            rc0 = *(const u32x4*)zp; rc1 = *(const u32x4*)(zp + 768);
            if (t > 0) rcm = *(const u32x4*)(zp - 768);
            if (t + 2 < L) rc2 = *(const u32x4*)(zp + 2 * 768);
        } else { const bf16* gp = G + (size_t)(row0 + t) * 1024 + c0 + ch * 8; rc0 = *(const u32x4*)gp; rc1 = *(const u32x4*)(gp + 1024); }
    };
    const int st0 = bid >> 4;
    if (bid >= nst * 16) return;
    if (st0 < NSEQ) tload(st0);
    int it = 0;
    for (int st = st0; st < NSEQ; st += nst, ++it) {
        int b, t0, L, row0; size_t obase; seq(st, b, t0, L, row0, obase);
        float oa[8], ob[8];
        if (kind < 3) {
#pragma unroll
            for (int q = 0; q < 4; ++q) {
                oa[2 * q] = bflo(rcm[q]) * w0[2 * q] + bflo(rc0[q]) * w1[2 * q] + bflo(rc1[q]) * w2[2 * q];
                oa[2 * q + 1] = bfhi(rcm[q]) * w0[2 * q + 1] + bfhi(rc0[q]) * w1[2 * q + 1] + bfhi(rc1[q]) * w2[2 * q + 1];
                ob[2 * q] = bflo(rc0[q]) * w0[2 * q] + bflo(rc1[q]) * w1[2 * q] + bflo(rc2[q]) * w2[2 * q];
                ob[2 * q + 1] = bfhi(rc0[q]) * w0[2 * q + 1] + bfhi(rc1[q]) * w1[2 * q + 1] + bfhi(rc2[q]) * w2[2 * q + 1];
            }
        } else {
#pragma unroll
            for (int q = 0; q < 4; ++q) { oa[2 * q] = siluf(bflo(rc0[q])); oa[2 * q + 1] = siluf(bfhi(rc0[q])); ob[2 * q] = siluf(bflo(rc1[q])); ob[2 * q + 1] = siluf(bfhi(rc1[q])); }
        }
        if (st + nst < NSEQ) tload(st + nst);
        bf16* tile = tiles + (it & 1) * (128 * TP);
        unsigned* trow = (unsigned*)(tile + (2 * rr) * TP + ch * 8);
        trow[0] = cvtpk_n(oa[0], oa[1]); trow[1] = cvtpk_n(oa[2], oa[3]); trow[2] = cvtpk_n(oa[4], oa[5]); trow[3] = cvtpk_n(oa[6], oa[7]);
        unsigned* trow2 = trow + TP / 2;
        trow2[0] = cvtpk_n(ob[0], ob[1]); trow2[1] = cvtpk_n(ob[2], ob[3]); trow2[2] = cvtpk_n(ob[4], ob[5]); trow2[3] = cvtpk_n(ob[6], ob[7]);
        __syncthreads();
        const bf16* tc = tile + (ch * 16) * TP + rr;
        u32x4 wa, wb;
        wa.x = (unsigned)tc[0] | ((unsigned)tc[TP] << 16); wa.y = (unsigned)tc[2 * TP] | ((unsigned)tc[3 * TP] << 16);
        wa.z = (unsigned)tc[4 * TP] | ((unsigned)tc[5 * TP] << 16); wa.w = (unsigned)tc[6 * TP] | ((unsigned)tc[7 * TP] << 16);
        wb.x = (unsigned)tc[8 * TP] | ((unsigned)tc[9 * TP] << 16); wb.y = (unsigned)tc[10 * TP] | ((unsigned)tc[11 * TP] << 16);
        wb.z = (unsigned)tc[12 * TP] | ((unsigned)tc[13 * TP] << 16); wb.w = (unsigned)tc[14 * TP] | ((unsigned)tc[15 * TP] << 16);
        bf16* op = HT + obase + ((size_t)kind * 256 + c0 + rr) * L + t0 + ch * 16;
        *(u32x4*)op = wa; *(u32x4*)(op + 8) = wb;
    }
    __syncthreads();
}

__device__ __forceinline__ void hyena_task(const P& p, int l, int task, unsigned char* smem) {
    float2* X = (float2*)smem; float2* TW = X + XLEN;
    const int tid = tidx();
    bf16* HT = (bf16*)(p.ws + WS_HMIX);
    const float* bias = p.in[I_HYBIAS] + l * 512;
    const int c = task >> 2, pr = task & 3; const int b0 = 2 * pr, b1 = 2 * pr + 1;
    const float bs0 = bias[c], bs1 = bias[256 + c];
    fft_load_tw(TW, (const float2*)(p.ws + WS_TW));
    const int t0 = tid * 8;
    bf16* base0 = HT + ((size_t)(b0 * 4) * 256 + c) * LAT + t0; bf16* base1 = HT + ((size_t)(b1 * 4) * 256 + c) * LAT + t0;
    const size_t KS = (size_t)256 * LAT;
    const u32x4 v0 = *(const u32x4*)(base0), v1 = *(const u32x4*)(base1);
    float va[8], vb[8];
#pragma unroll
    for (int q = 0; q < 4; ++q) { va[2 * q] = bflo(v0[q]); va[2 * q + 1] = bfhi(v0[q]); vb[2 * q] = bflo(v1[q]); vb[2 * q + 1] = bfhi(v1[q]); }
    const int xb = t0 + (tid >> 2);
    const int zb = PADI(4096 + t0);
#pragma unroll
    for (int j = 0; j < 8; ++j) { X[xb + j] = make_float2(va[j], vb[j]); X[zb + j] = make_float2(0.f, 0.f); }
    __syncthreads();
    float ya[8], yb[8];
    const u32x2* KH0 = (const u32x2*)((const unsigned*)(p.ws + WS_KHAT + (size_t)(l & 1) * KHAT_COPY) + (size_t)c * NFFT);
    const u32x2* KH1 = (const u32x2*)((const unsigned*)(p.ws + WS_KHAT + (size_t)(l & 1) * KHAT_COPY) + (size_t)(256 + c) * NFFT);
    u32x2 kh[8];
#pragma unroll
    for (int i = 0; i < 8; ++i) kh[i] = KH0[tid + NT * i];
    u32x4 xa0 = *(const u32x4*)(base0 + KS), xa1 = *(const u32x4*)(base1 + KS);
    u32x4 g0 = {0u, 0u, 0u, 0u}, g1 = {0u, 0u, 0u, 0u};
#pragma unroll
    for (int o = 0; o < 2; ++o) {
        fft_fwd_hi(X, TW);
#pragma unroll
        for (int i = 0; i < 8; ++i) {
            int pi = tid + NT * i; float2 a = X[PADI(2 * pi)], bq = X[PADI(2 * pi + 1)];
            const u32x2 kk = kh[i];
            float2 u = make_float2(a.x + bq.x, a.y + bq.y), v = make_float2(a.x - bq.x, a.y - bq.y);
            u = cmul(u, make_float2(bflo(kk.x), bfhi(kk.x))); v = cmul(v, make_float2(bflo(kk.y), bfhi(kk.y)));
            X[PADI(2 * pi)] = make_float2(u.x + v.x, u.y + v.y); X[PADI(2 * pi + 1)] = make_float2(u.x - v.x, u.y - v.y);
        }
        __syncthreads();
        if (o == 0) {
#pragma unroll
            for (int i = 0; i < 8; ++i) kh[i] = KH1[tid + NT * i];
            g0 = *(const u32x4*)(base0 + 3 * KS); g1 = *(const u32x4*)(base1 + 3 * KS);
        }
        fft_inv_hi(X, TW);
        if (o == 0) {
#pragma unroll
            for (int j = 0; j < 8; ++j) {
                const float2 cvv = X[xb + j];
                const float xa = (j & 1) ? bfhi(xa0[j >> 1]) : bflo(xa0[j >> 1]), xbv = (j & 1) ? bfhi(xa1[j >> 1]) : bflo(xa1[j >> 1]);
                ya[j] = xa * (cvv.x + bs0 * va[j]); yb[j] = xbv * (cvv.y + bs0 * vb[j]);
                X[xb + j] = make_float2(ya[j], yb[j]); X[zb + j] = make_float2(0.f, 0.f);
            }
            xa0 = *(const u32x4*)(base0 + 2 * KS); xa1 = *(const u32x4*)(base1 + 2 * KS);
            __syncthreads();
        } else {
            float oa[8], ob[8];
#pragma unroll
            for (int j = 0; j < 8; ++j) {
                const float2 cvv = X[xb + j];
                const float xa = (j & 1) ? bfhi(xa0[j >> 1]) : bflo(xa0[j >> 1]), xbv = (j & 1) ? bfhi(xa1[j >> 1]) : bflo(xa1[j >> 1]);
                const float ga = (j & 1) ? bfhi(g0[j >> 1]) : bflo(g0[j >> 1]), gb = (j & 1) ? bfhi(g1[j >> 1]) : bflo(g1[j >> 1]);
                oa[j] = xa * (cvv.x + bs1 * ya[j]) * ga; ob[j] = xbv * (cvv.y + bs1 * yb[j]) * gb;
            }
            u32x4 wa, wb;
            wa.x = cvtpk_n(oa[0], oa[1]); wa.y = cvtpk_n(oa[2], oa[3]); wa.z = cvtpk_n(oa[4], oa[5]); wa.w = cvtpk_n(oa[6], oa[7]);
            wb.x = cvtpk_n(ob[0], ob[1]); wb.y = cvtpk_n(ob[2], ob[3]); wb.z = cvtpk_n(ob[4], ob[5]); wb.w = cvtpk_n(ob[6], ob[7]);
            *(u32x4*)base0 = wa; *(u32x4*)base1 = wb;
            __syncthreads();
        }
    }
}
__device__ __forceinline__ void hyena_ctx_task(const P& p, int l, int task2, unsigned char* smem) {
    const int half = tidx() >> 8, t = tidx() & 255;
    float* u = (float*)smem + half * 768; float* G = u + 256;
    const bf16* HT = (const bf16*)(p.ws + WS_HMIX) + HYT_CTX_OFF; bf16* MIX = (bf16*)(p.ws + WS_MIX);
    const float* bias = p.in[I_HYBIAS] + l * 512; const float* HC = (const float*)(p.ws + ((l & 1) ? WS_HCTX2 : WS_HCTX));
    const int task = task2 * 2 + half;
    const int b = task >> 8, c = task & 255; const size_t m = row_ctx(b, t);
    const bf16* hb0 = HT + ((size_t)(b * 4) * 256 + c) * CTX + t; const size_t KS = (size_t)256 * CTX;
    const float v = bf2f(hb0[0]), x1 = bf2f(hb0[KS]), x2 = bf2f(hb0[2 * KS]), sg = bf2f(hb0[3 * KS]);
    float cur = v, res = 0.f;
    const float* Gt = G + (255 - t);
    for (int o = 0; o < 2; ++o) {
        const float hfv = HC[((o * 2 + 0) * 256 + c) * 256 + t], hbv = HC[((o * 2 + 1) * 256 + c) * 256 + t];
        __syncthreads();
        u[t] = cur; G[255 - t] = hfv; if (t > 0) G[255 + t] = hbv;
        if (t == 0) G[511] = 0.f;
        __syncthreads();
        float acc0 = 0.f, acc1 = 0.f, acc2 = 0.f, acc3 = 0.f;
        for (int s = 0; s < CTX; s += 32) {
            f32x4 uu[8]; float gv[32];
#pragma unroll
            for (int k = 0; k < 8; ++k) uu[k] = *(const f32x4*)(u + s + 4 * k);
#pragma unroll
            for (int k = 0; k < 32; ++k) gv[k] = Gt[s + k];
            __builtin_amdgcn_sched_barrier(0);
#pragma unroll
            for (int k = 0; k < 8; ++k) { acc0 += uu[k].x * gv[4 * k]; acc1 += uu[k].y * gv[4 * k + 1]; acc2 += uu[k].z * gv[4 * k + 2]; acc3 += uu[k].w * gv[4 * k + 3]; }
            __builtin_amdgcn_sched_barrier(0);
        }
        const float acc = (acc0 + acc1) + (acc2 + acc3);
        float y = (o == 0 ? x1 : x2) * (acc + bias[o * 256 + c] * cur);
        cur = y; res = y;
    }
    MIX[m * 1024 + c] = f2bf(res * sg);
    __syncthreads();
}
__device__ __forceinline__ void ph_hy_out(const P& p, unsigned char* smem, int bid, int nblk) {
    const int tid = tidx(), rr = tid >> 3, ch = tid & 7;
    const bf16* HT = (const bf16*)(p.ws + WS_HMIX); bf16* MIX = (bf16*)(p.ws + WS_MIX);
    auto hload = [&](int tl) -> u32x4 { const int ct = tl & 3, tt = (tl >> 2) & 63, b = tl >> 8;
        return *(const u32x4*)(HT + ((size_t)(b * 4) * 256 + ct * 64 + rr) * LAT + tt * 64 + ch * 8); };
    u32x4 wn = {0u, 0u, 0u, 0u};
    if (bid < 2048) wn = hload(bid);
    int it = 0;
    for (int tl = bid; tl < 2048; tl += nblk, ++it) {
        const int ct = tl & 3, tt = (tl >> 2) & 63, b = tl >> 8; const int c0 = ct * 64, t0 = tt * 64;
        const u32x4 w = wn;
        if (tl + nblk < 2048) wn = hload(tl + nblk);
        bf16* tile = (bf16*)smem + (it & 1) * (64 * HPT);
        tile[(ch * 8 + 0) * HPT + rr] = (bf16)(w.x & 0xffff); tile[(ch * 8 + 1) * HPT + rr] = (bf16)(w.x >> 16);
        tile[(ch * 8 + 2) * HPT + rr] = (bf16)(w.y & 0xffff); tile[(ch * 8 + 3) * HPT + rr] = (bf16)(w.y >> 16);
        tile[(ch * 8 + 4) * HPT + rr] = (bf16)(w.z & 0xffff); tile[(ch * 8 + 5) * HPT + rr] = (bf16)(w.z >> 16);
        tile[(ch * 8 + 6) * HPT + rr] = (bf16)(w.w & 0xffff); tile[(ch * 8 + 7) * HPT + rr] = (bf16)(w.w >> 16);
        __syncthreads();
        const u32x4 o = *(const u32x4*)(tile + rr * HPT + ch * 8);
        *(u32x4*)(MIX + (size_t)row_lat(b, t0 + rr) * 1024 + c0 + ch * 8) = o;
    }
    __syncthreads();
}

constexpr int ALD = 72;
__device__ __forceinline__ int kperm(int i) { return (i & ~12) | ((i & 8) >> 1) | ((i & 4) << 1); }
__device__ __forceinline__ void attn_task(const P& p, int l, int task, unsigned char* smem) {
    bf16* Ks = (bf16*)smem; bf16* Vs = Ks + 64 * ALD;
    const int tid = tidx(), lane = tid & 63, wave = tid >> 6, r = lane & 31, hh = lane >> 5;
    int kind, rem;
    if (task < 512) { kind = 1; rem = task; } else if (task < 1024) { kind = 0; rem = task - 512; } else if (task < 1056) { kind = 2; rem = task - 1024; } else { kind = 3; rem = task - 1056; }
    const bool win = (kind == 0 || kind == 2), qctx = kind >= 2;
    const int nqb = qctx ? 2 : 32;
    const int qb = rem % nqb, kvh = (rem / nqb) & 1, b = rem / (nqb * 2), h = kvh * 2 + (wave >> 2);
    const bf16* ZQ = (const bf16*)(p.ws + (win ? WS_ZWA : WS_ZFA));
    const bf16* VT = (const bf16*)(p.ws + (win ? WS_VTW : WS_VTF)) + (size_t)(b * 2 + kvh) * 64 * SKV;
    bf16* MIX = (bf16*)(p.ws + WS_MIX); const bf16* G = (const bf16*)(p.ws + WS_GATES);
    const int mixc = (win ? 512 : 768) + h * 64;
    const int q0 = qb * 128;
    const int qpos = q0 + (wave & 3) * 32 + r;
    const size_t qrow = qctx ? row_ctx(b, qpos) : row_lat(b, qpos);
    const bool enabled = win ? (EN_C != 0) : (EN_D != 0);
    if (!enabled) {
        for (int i = tid; i < 128 * 128; i += NT) { int rr = i >> 7, cc = i & 127; size_t rw = qctx ? row_ctx(b, q0 + rr) : row_lat(b, q0 + rr); MIX[rw * 1024 + (win ? 512 : 768) + kvh * 128 + cc] = 0; }
        return;
    }
    bf16x8 qf[4];
    {
        u32x4 raw[4]; f32x4 gqv[8], csv[8];
#pragma unroll
        for (int s = 0; s < 4; ++s) raw[s] = *(const u32x4*)(ZQ + qrow * 384 + h * 64 + s * 16 + hh * 8);
        if (!win) {
            const float* gq = p.in[I_FAQN] + l * 64 + hh * 8;
#pragma unroll
            for (int s = 0; s < 4; ++s) { gqv[2 * s] = *(const f32x4*)(gq + s * 16); gqv[2 * s + 1] = *(const f32x4*)(gq + s * 16 + 4); }
        }
        if (!qctx) {
            const float* cs = (const float*)((const float2*)(p.ws + WS_ROPE) + qpos * 32 + hh * 8);
#pragma unroll
            for (int sec = 0; sec < 2; ++sec)
#pragma unroll
                for (int k = 0; k < 4; ++k) csv[4 * sec + k] = *(const f32x4*)(cs + sec * 32 + 4 * k);
        }
        __builtin_amdgcn_sched_barrier(0);
        float qv[4][8];
#pragma unroll
        for (int s = 0; s < 4; ++s) {
            qv[s][0] = bflo(raw[s].x); qv[s][1] = bfhi(raw[s].x); qv[s][2] = bflo(raw[s].y); qv[s][3] = bfhi(raw[s].y); qv[s][4] = bflo(raw[s].z); qv[s][5] = bfhi(raw[s].z); qv[s][6] = bflo(raw[s].w); qv[s][7] = bfhi(raw[s].w); }
        float qs = 0.125f * 1.4426950408889634f;
        if (!win) {
            float ss = 0.f;
#pragma unroll
            for (int s = 0; s < 4; ++s)
#pragma unroll
                for (int j = 0; j < 8; ++j) ss += qv[s][j] * qv[s][j];
            ss += __shfl_xor(ss, 32);
            const float rs = rsqrtf(ss * (1.0f / 64.0f) + 1e-6f);
#pragma unroll
            for (int s = 0; s < 4; ++s)
#pragma unroll
                for (int j = 0; j < 8; ++j) qv[s][j] *= rs * gqv[2 * s + (j >> 2)][j & 3];
        }
        if (!qctx) {
#pragma unroll
            for (int sec = 0; sec < 2; ++sec)
#pragma unroll
                for (int j = 0; j < 8; ++j) { const f32x4 cc = csv[4 * sec + (j >> 1)]; const float cx = (j & 1) ? cc.z : cc.x, cy = (j & 1) ? cc.w : cc.y;
                    const float xa = qv[2 * sec][j], xb = qv[2 * sec + 1][j];
                    qv[2 * sec][j] = xa * cx - xb * cy; qv[2 * sec + 1][j] = xb * cx + xa * cy; }
        }
#pragma unroll
        for (int s = 0; s < 4; ++s) { u32x4 w; w.x = cvtpk_n(qv[s][0] * qs, qv[s][1] * qs); w.y = cvtpk_n(qv[s][2] * qs, qv[s][3] * qs); w.z = cvtpk_n(qv[s][4] * qs, qv[s][5] * qs); w.w = cvtpk_n(qv[s][6] * qs, qv[s][7] * qs);
            qf[s] = __builtin_bit_cast(bf16x8, w); }
    }
    f32x16 oacc[2];
#pragma unroll
    for (int e = 0; e < 16; ++e) { oacc[0][e] = 0.f; oacc[1][e] = 0.f; }
    float mrun = -1e30f, lrun = 0.f;
    int ntile, lt0 = 0;
    if (qctx) ntile = 4;
    else if (!win) ntile = 68;
    else { int lo = q0 - 128; if (lo < 0) lo = 0; int hi = q0 + 256; if (hi > LAT) hi = LAT; lt0 = lo / 64; ntile = 4 + (hi - lo) / 64; }
    bf16* Vb = Ks + 2 * 64 * ALD;
    const bool grpB = __builtin_amdgcn_readfirstlane(wave) >= 4;
    const int srw = tid >> 3, sch = tid & 7;
    auto tile_key0 = [&](int ti) -> int { const int kt = (ti < 4) ? ti : (win ? (4 + lt0 + (ti - 4)) : ti); return kt * 64; };
    u32x4 kregA, vregA, kregB, vregB;
    auto tile_load = [&](int ti, u32x4& kreg, u32x4& vreg) {
        const int key0 = tile_key0(ti);
        const size_t krow0 = (key0 < CTX) ? (size_t)row_ctx(b, key0) : (size_t)row_lat(b, key0 - CTX);
        kreg = *(const u32x4*)(ZQ + (krow0 + srw) * 384 + 256 + kvh * 64 + sch * 8);
        vreg = *(const u32x4*)(VT + (size_t)srw * SKV + key0 + sch * 8);
    };
    bf16x8 pf[2][2], kf[2][4], vf[2][2][2];
    auto kload = [&](int ti) {
        const bf16* Kc = Ks + (ti & 1) * (64 * ALD);
#pragma unroll
        for (int sub = 0; sub < 2; ++sub)
#pragma unroll
            for (int s = 0; s < 4; ++s) kf[sub][s] = *(const bf16x8*)(Kc + (sub * 32 + kperm(r)) * ALD + s * 16 + hh * 8);
    };
    auto vload1 = [&](int vslot, int dt) {
        const bf16* Vc = Vb + vslot * (64 * ALD);
#pragma unroll
        for (int sub = 0; sub < 2; ++sub)
#pragma unroll
            for (int s2 = 0; s2 < 2; ++s2) vf[dt][sub][s2] = *(const bf16x8*)(Vc + (dt * 32 + r) * ALD + sub * 32 + s2 * 16 + hh * 8);
    };
    auto vload = [&](int vslot) { vload1(vslot, 0); vload1(vslot, 1); };
    auto pv = [&]() {
        __builtin_amdgcn_s_setprio(1);
#pragma unroll
        for (int dt = 0; dt < 2; ++dt)
#pragma unroll
            for (int sub = 0; sub < 2; ++sub)
#pragma unroll
                for (int s2 = 0; s2 < 2; ++s2) oacc[dt] = __builtin_amdgcn_mfma_f32_32x32x16_bf16(vf[dt][sub][s2], pf[sub][s2], oacc[dt], 0, 0, 0);
        __builtin_amdgcn_s_setprio(0);
    };
    auto qk_sm = [&](int ti, int vslot) {
        const int key0 = tile_key0(ti);
        f32x16 sc[2];
        __builtin_amdgcn_s_setprio(1);
#pragma unroll
        for (int sub = 0; sub < 2; ++sub) {
#pragma unroll
            for (int e = 0; e < 16; ++e) sc[sub][e] = 0.f;
#pragma unroll
            for (int s = 0; s < 4; ++s) sc[sub] = __builtin_amdgcn_mfma_f32_32x32x16_bf16(kf[sub][s], qf[s], sc[sub], 0, 0, 0);
        }
        __builtin_amdgcn_s_setprio(0);
        if (vslot >= 0) { vload1(vslot, 0); __builtin_amdgcn_sched_barrier(0); }
        if (win && key0 >= CTX) {
#pragma unroll
            for (int sub = 0; sub < 2; ++sub)
#pragma unroll
                for (int e = 0; e < 16; ++e) {
                    int kpos = key0 - CTX + sub * 32 + 16 * (e >> 3) + 8 * hh + (e & 7);
                    int dlt = qpos - kpos; if (dlt < 0) dlt = -dlt;
                    if (dlt > 128) sc[sub][e] = -1e30f;
                }
        }
        float mx = sc[0][0];
#pragma unroll
        for (int e = 1; e < 16; ++e) mx = fmaxf(mx, sc[0][e]);
#pragma unroll
        for (int e = 0; e < 16; ++e) mx = fmaxf(mx, sc[1][e]);
        { const unsigned um = __float_as_uint(mx); auto rr = __builtin_amdgcn_permlane32_swap(um, um, false, false); mx = fmaxf(__uint_as_float(rr[0]), __uint_as_float(rr[1])); }
        if (__any(mx > mrun + 8.0f)) {
            const float mnew = fmaxf(mrun, mx);
            const float alpha = __builtin_amdgcn_exp2f(mrun - mnew);
            mrun = mnew; lrun *= alpha;
#pragma unroll
            for (int e = 0; e < 16; ++e) { oacc[0][e] *= alpha; oacc[1][e] *= alpha; }
        }
        float ps = 0.f;
#pragma unroll
        for (int sub = 0; sub < 2; ++sub)
#pragma unroll
            for (int s2 = 0; s2 < 2; ++s2) {
                float pe[8];
#pragma unroll
                for (int jj = 0; jj < 8; ++jj) { pe[jj] = __builtin_amdgcn_exp2f(sc[sub][8 * s2 + jj] - mrun); ps += pe[jj]; }
                u32x4 w; w.x = cvtpk_n(pe[0], pe[1]); w.y = cvtpk_n(pe[2], pe[3]); w.z = cvtpk_n(pe[4], pe[5]); w.w = cvtpk_n(pe[6], pe[7]);
                pf[sub][s2] = __builtin_bit_cast(bf16x8, w);
            }
        lrun += ps;
    };
    auto tile_store = [&](int ti, int vslot, const u32x4& kreg, const u32x4& vreg) {
        *(u32x4*)(Ks + (ti & 1) * (64 * ALD) + srw * ALD + sch * 8) = kreg; *(u32x4*)(Vb + vslot * (64 * ALD) + srw * ALD + sch * 8) = vreg;
    };
    __syncthreads();
    tile_load(0, kregA, vregA);
    tile_load(1, kregB, vregB);
    tile_store(0, 0, kregA, vregA);
    __syncthreads();
    int vs0 = 0;
    for (int ti = 0; ti < ntile; ti += 2) {
        const int vs1 = vs0 == 2 ? 0 : vs0 + 1, vs2 = vs1 == 2 ? 0 : vs1 + 1;
        if (ti + 2 < ntile) tile_load(ti + 2, kregA, vregA);
        if (grpB) { if (ti > 0) { vload(vs2); __builtin_amdgcn_sched_barrier(0); pv(); } kload(ti); __builtin_amdgcn_sched_barrier(0); qk_sm(ti, -1); }
        else { kload(ti); __builtin_amdgcn_sched_barrier(0); qk_sm(ti, vs0); vload1(vs0, 1); __builtin_amdgcn_sched_barrier(0); pv(); }
        tile_store(ti + 1, vs1, kregB, vregB);
        __syncthreads();
        if (ti + 3 < ntile) tile_load(ti + 3, kregB, vregB);
        if (grpB) { vload(vs0); __builtin_amdgcn_sched_barrier(0); pv(); kload(ti + 1); __builtin_amdgcn_sched_barrier(0); qk_sm(ti + 1, -1); }
        else { kload(ti + 1); __builtin_amdgcn_sched_barrier(0); qk_sm(ti + 1, vs1); vload1(vs1, 1); __builtin_amdgcn_sched_barrier(0); pv(); }
        if (ti + 2 < ntile) tile_store(ti + 2, vs2, kregA, vregA);
        __syncthreads();
        vs0 = vs2;
    }
    if (grpB) { vload(vs0 == 0 ? 2 : vs0 - 1); pv(); }
    lrun += __shfl_xor(lrun, 32);
    if (win) lrun += __builtin_amdgcn_exp2f(p.in[I_WASINK][l * 4 + h] * 1.4426950408889634f - mrun);
    const float inv = 1.0f / lrun;
    u32x2 gvs[2][4];
#pragma unroll
    for (int dt = 0; dt < 2; ++dt)
#pragma unroll
        for (int g = 0; g < 4; ++g) gvs[dt][g] = *(const u32x2*)(G + qrow * 1024 + mixc + dt * 32 + 8 * g + 4 * hh);
    __builtin_amdgcn_sched_barrier(0);
#pragma unroll
    for (int dt = 0; dt < 2; ++dt)
#pragma unroll
        for (int g = 0; g < 4; ++g) {
            int d0 = dt * 32 + 8 * g + 4 * hh;
            const u32x2 gv = gvs[dt][g];
            float g0 = bf2f((bf16)(gv.x & 0xffff)), g1 = bf2f((bf16)(gv.x >> 16)), g2 = bf2f((bf16)(gv.y & 0xffff)), g3 = bf2f((bf16)(gv.y >> 16));
            u32x2 w; w.x = pk2(oacc[dt][4 * g] * inv * siluf(g0), oacc[dt][4 * g + 1] * inv * siluf(g1));
            w.y = pk2(oacc[dt][4 * g + 2] * inv * siluf(g2), oacc[dt][4 * g + 3] * inv * siluf(g3));
            *(u32x2*)(MIX + qrow * 1024 + mixc + d0) = w;
        }
    __syncthreads();
}

constexpr int MIX_NATT = 1088, MIX_NHY = 1024, MIX_NHYC = 1024;
constexpr int MIX_NWC = 148, MIX_NFL = 1024;
__device__ __forceinline__ void ph_mixer(const P& p, int l, unsigned char* smem, int bid, int nblk) {
    volatile int* s_task = (volatile int*)(smem + LDS_BYTES - 16);
    if (bid < 64) {
#if EN_B
#if PROBE
        unsigned long long t0 = __builtin_amdgcn_s_memrealtime();
#endif
        rw_scan_chunked(p, l, bid, smem);
#if PROBE
        if (bid == 0 && l == 1 && tidx() == 0) ((unsigned long long*)(p.ws + WS_CTL))[256 + 1] = __builtin_amdgcn_s_memrealtime() - t0;
#endif
#endif
    }
    unsigned* ctr = (unsigned*)(p.ws + WS_CTL) + 64 * (1 + l);
    const int natt = (l < DEPTH - 1) ? MIX_NATT : 1024;
    const int ntask = natt + MIX_NHY + (l < DEPTH - 1 ? MIX_NHYC + MIX_NWC + MIX_NFL : 0);
    auto ctrv_f = [&]() -> unsigned* { int z = tidx() & 0; asm volatile("" : "+v"(z)); return (unsigned*)(p.ws + WS_CTL) + 64 * (1 + l) + z; };
    __syncthreads();
    if (tidx() == 0) *s_task = (int)__hip_atomic_fetch_add(ctrv_f(), 1u, __ATOMIC_RELAXED, __HIP_MEMORY_SCOPE_AGENT);
    __syncthreads();
    int t = __builtin_amdgcn_readfirstlane(*s_task);
    while (t < ntask) {
        unsigned pre = 0u;
        if (tidx() == 0) pre = __hip_atomic_fetch_add(ctrv_f(), 1u, __ATOMIC_RELAXED, __HIP_MEMORY_SCOPE_AGENT);
        P q = p; FENCE(q);
        if (t < natt) attn_task(q, l, t, smem);
        else if (t < natt + MIX_NHY) hyena_task(q, l, t - natt, smem);
        else if (t < MIX_NATT + MIX_NHY + MIX_NHYC) hyena_ctx_task(q, l, t - MIX_NATT - MIX_NHY, smem);
        else if (t < MIX_NATT + MIX_NHY + MIX_NHYC + MIX_NWC) ph_wconv(q, l + 1, smem, t - (MIX_NATT + MIX_NHY + MIX_NHYC), MIX_NWC);
        else hy_filt_task(q, l + 1, t - (MIX_NATT + MIX_NHY + MIX_NHYC + MIX_NWC), smem);
        __syncthreads();
        if (tidx() == 0) *s_task = (int)pre;
        __syncthreads();
        t = __builtin_amdgcn_readfirstlane(*s_task);
    }
}

__device__ __forceinline__ void ph_final(const P& p, int bid, int nblk) {
    const int lane = tidx() & 63, wave = tidx() >> 6;
    const float* g = p.in[I_FINALG];
    f32x4 gq[4];
#pragma unroll
    for (int j = 0; j < 4; ++j) gq[j] = *(const f32x4*)(g + 256 * j + 4 * lane);
    for (int m = bid * 8 + wave; m < MLAT; m += nblk * 8) {
        float* src = p.out + (size_t)m * 1024;
        const bf16* sb = (const bf16*)(p.ws + WS_HMIX) + (size_t)m * 1024;
        f32x4 v[4]; float s = 0.f;
#pragma unroll
        for (int j = 0; j < 4; ++j) { const u32x2 r = *(const u32x2*)(sb + 256 * j + 4 * lane); v[j].x = bflo(r.x); v[j].y = bfhi(r.x); v[j].z = bflo(r.y); v[j].w = bfhi(r.y);
            s += v[j].x * v[j].x + v[j].y * v[j].y + v[j].z * v[j].z + v[j].w * v[j].w; }
        s = wave_sum(s);
        float rs = rsqrtf(s * (1.0f / 1024.0f) + 1e-6f);
#pragma unroll
        for (int j = 0; j < 4; ++j) { const f32x4 gg = gq[j]; f32x4 o; o.x = v[j].x * rs * gg.x; o.y = v[j].y * rs * gg.y; o.z = v[j].z * rs * gg.z; o.w = v[j].w * rs * gg.w; *(f32x4*)(src + 256 * j + 4 * lane) = o; }
    }
}

#define LAS __attribute__((address_space(3)))
#define XB_TMO      128
#define XB_XCNT(j)  (256  + 64 * (j))
#define XB_XSUB(j)  (1280 + 64 * (j))
#define XB_XGEN(j)  (2304 + 64 * (j))
#define XB_TOP      3328
#define XB_TOPGEN   3392
#define XCD_BAR_WORDS 3456
#define XB_SPIN_CAP (1u << 18)

__device__ __forceinline__ unsigned xb_ld(unsigned* p)              { return __hip_atomic_load(p, __ATOMIC_RELAXED, __HIP_MEMORY_SCOPE_AGENT); }
__device__ __forceinline__ unsigned xb_add(unsigned* p, unsigned v) { return __hip_atomic_fetch_add(p, v, __ATOMIC_RELAXED, __HIP_MEMORY_SCOPE_AGENT); }
__device__ __forceinline__ unsigned xb_xcc_id() { return (unsigned)__builtin_amdgcn_s_getreg((3 << 11) | 20) & 0xFu; }
#define XB_SPIN(cond, bar) do { unsigned _sp = 0; while (cond) { __builtin_amdgcn_s_sleep(1); \
    if ((++_sp & 255u) == 0u) { if (xb_ld(&(bar)[XB_TMO])) break; if (_sp > XB_SPIN_CAP) { atomicAdd(&(bar)[XB_TMO], 1u); break; } } } } while (0)

struct XcdBarrier {
    unsigned* bar; unsigned x;
    volatile LAS unsigned* st;
};

__device__ __forceinline__ XcdBarrier xcd_barrier_post(unsigned* bar, volatile LAS unsigned* st) {
    XcdBarrier b; b.bar = bar; b.x = xb_xcc_id(); b.st = st;
    if (threadIdx.x == 0) (void)xb_add(&bar[XB_XCNT(b.x)], 1u);
    return b;
}
__device__ __forceinline__ void xcd_barrier_complete(unsigned* bar, unsigned x, unsigned& nloc, unsigned& nx) {
    const unsigned G = gridDim.x * gridDim.y * gridDim.z;
    unsigned sum, cnt, mine, sp = 0u;
    for (;;) {
        sum = 0u; cnt = 0u; mine = 0u;
#pragma unroll
        for (unsigned j = 0; j < 16; ++j) { const unsigned c = xb_ld(&bar[XB_XCNT(j)]); sum += c; cnt += (c > 0u) ? 1u : 0u; mine = (j == x) ? c : mine; }
        if (sum == G) break;
        __builtin_amdgcn_s_sleep(1);
        if ((++sp & 255u) == 0u) { if (xb_ld(&bar[XB_TMO])) break; if (sp > XB_SPIN_CAP) { atomicAdd(&bar[XB_TMO], 1u); break; } }
    }
    nloc = mine > 0u ? mine : 1u; nx = cnt > 0u ? cnt : 1u;
}

__device__ __forceinline__ void xcd_barrier(const XcdBarrier& b) {
    asm volatile("s_waitcnt vmcnt(0)" ::: "memory");
    __syncthreads();
    if (threadIdx.x == 0) {
        unsigned* bar = b.bar;
        __builtin_amdgcn_s_waitcnt(0);
        unsigned nloc = b.st[0], nx = b.st[1];
        if (nloc == 0u) { xcd_barrier_complete(bar, b.x, nloc, nx); b.st[0] = nloc; b.st[1] = nx; }
        const unsigned old = xb_add(&bar[XB_XSUB(b.x)], 1u);
        const unsigned gen = old / nloc;
        if (old + 1u == (gen + 1u) * nloc) {
            __builtin_amdgcn_fence(__ATOMIC_RELEASE, "agent");
            asm volatile("s_waitcnt vmcnt(0)" ::: "memory");
            const unsigned og = xb_add(&bar[XB_TOP], 1u);
            const unsigned tg = og / nx;
            if (og + 1u == (tg + 1u) * nx) xb_add(&bar[XB_TOPGEN], 1u);
            else XB_SPIN(xb_ld(&bar[XB_TOPGEN]) == tg, bar);
            __builtin_amdgcn_fence(__ATOMIC_ACQUIRE, "agent");
            xb_add(&bar[XB_XGEN(b.x)], 1u);
            asm volatile("s_waitcnt vmcnt(0)" ::: "memory");
        } else {
            XB_SPIN(xb_ld(&bar[XB_XGEN(b.x)]) == gen, bar);
            __builtin_amdgcn_fence(__ATOMIC_ACQUIRE, "agent");
            asm volatile("s_waitcnt vmcnt(0)" ::: "memory");
        }
    }
    __syncthreads();
}

__global__ void __launch_bounds__(NT) mega(KP kp) {
    extern __shared__ __attribute__((aligned(16))) unsigned char smem[];
    cg::grid_group grid = cg::this_grid();
    const int bid = blockIdx.x, nblk = gridDim.x;
    volatile LAS unsigned* xst = (volatile LAS unsigned*)((LAS unsigned char*)smem + LDS_BYTES - 32);
    if (threadIdx.x < 2) xst[threadIdx.x] = 0u;
    __syncthreads();
    if (bid == 0) {
#pragma unroll
        for (int i = 0; i < 8; ++i) ((uint4*)(kp.ws + WS_CTL))[threadIdx.x + NT * i] = make_uint4(0u, 0u, 0u, 0u);
    }
    P q; q.in.t = (intab_t)__builtin_amdgcn_kernarg_segment_ptr(); q.out = kp.out; q.ws = kp.ws;
    FENCE(q); ph_modv(q, smem, bid, nblk);
    FENCE(q); ph_tables(q, bid, nblk);
    FENCE(q); ph_wconv(q, 0, smem, bid, nblk);
    FENCE(q); ph_hy_mlp(q, 0, smem, bid, nblk);
    grid.sync();
    XcdBarrier xbar = xcd_barrier_post((unsigned*)(kp.ws + WS_CTL) + 1024, xst);
    for (int l = 0; l < DEPTH; ++l) {
        FENCE(q); ph_norm(q, l, bid, nblk);
        if (l == 0) { FENCE(q); ph_hraw(q, 0, bid, nblk); }
        xcd_barrier(xbar);
        FENCE(q);
        { pg8::Gemm g{(const bf16*)(q.ws + WS_HMIX), (const bf16*)(q.ws + ((l & 1) ? WS_WINT2 : WS_WINT)), MROWS, 3840, 1024}; pg8::StaticOrder S; S.init(MROWS, 3840, nblk, bid);
          EpiIn E{q.ws}; pg8::gemm_phase<EpiIn, pg8::StaticOrder, true, true>((PG8_LAS unsigned char*)smem, g, S, E); }
        if (l + 1 < DEPTH) { FENCE(q); ph_hy_mlp(q, l + 1, smem, bid, nblk); }
        if (l == 0) { FENCE(q); ph_hy_filt(q, 0, smem, bid, nblk); }
        xcd_barrier(xbar);
        FENCE(q); ph_rw_prep(q, l, smem, bid, nblk);
        FENCE(q); ph_attn_prep(q, l, bid, nblk);
        FENCE(q); ph_hy_prep(q, l, smem, bid, nblk);
        if (l + 1 < DEPTH) { FENCE(q); ph_hraw(q, l + 1, bid, nblk); }
        xcd_barrier(xbar);
#if PROBE
        unsigned long long tm0 = __builtin_amdgcn_s_memrealtime();
#endif
        FENCE(q); ph_mixer(q, l, smem, bid, nblk);
#if PROBE
        if (bid == 200 && l == 1 && tidx() == 0) ((unsigned long long*)(q.ws + WS_CTL))[256 + 3] = __builtin_amdgcn_s_memrealtime() - tm0;
#endif
        xcd_barrier(xbar);
#if PROBE
        if (bid == 0 && l == 1 && tidx() == 0) ((unsigned long long*)(q.ws + WS_CTL))[256 + 2] = __builtin_amdgcn_s_memrealtime() - tm0;
#endif
        if (l < DEPTH - 1) {
            FENCE(q); ph_rw_readout(q, l, MLAT, MROWS, bid, nblk);
            unsigned* cctr = (unsigned*)(q.ws + WS_CTL) + 320 + 16 * l;
            asm volatile("s_waitcnt vmcnt(0)" ::: "memory");
            __syncthreads();
            if (threadIdx.x == 0) { __builtin_amdgcn_fence(__ATOMIC_RELEASE, "agent"); asm volatile("s_waitcnt vmcnt(0)" ::: "memory"); (void)xb_add(cctr, 1u); }
            if (bid < 32) {
                if (threadIdx.x == 0) { XB_SPIN(xb_ld(cctr) < (unsigned)nblk, xbar.bar); __builtin_amdgcn_fence(__ATOMIC_ACQUIRE, "agent"); asm volatile("s_waitcnt vmcnt(0)" ::: "memory"); }
                __syncthreads();
                FENCE(q);
                pg8::Gemm g{(const bf16*)(q.ws + WS_MIX), (const bf16*)(q.ws + ((l & 1) ? WS_WOUTT2 : WS_WOUTT)), MROWS, 1024, 1024}; pg8::OneUnit S{MLAT / 256 + (bid >> 2), bid & 3};
                EpiOutT<true> E{(const bf16*)q.out, l == 0 ? q.in[I_CTX] : (const float*)(q.ws + WS_CTXS), (bf16*)q.out, (float*)(q.ws + WS_CTXS), (const float*)(q.ws + WS_MODV) + (size_t)l * 9 * 3072 + 2048};
                pg8::gemm_phase<EpiOutT<true>, pg8::OneUnit, true, true>((PG8_LAS unsigned char*)smem, g, S, E);
            } else {
                FENCE(q); ph_rw_readout(q, l, 0, MLAT, bid - 32, nblk - 32);
                FENCE(q); ph_hy_out(q, smem, bid - 32, nblk - 32);
            }
        } else {
            FENCE(q); ph_rw_readout(q, l, 0, MLAT, bid, nblk);
            FENCE(q); ph_hy_out(q, smem, bid, nblk);
        }
        xcd_barrier(xbar);
        FENCE(q);
        { const int Mo = MLAT;
          pg8::Gemm g{(const bf16*)(q.ws + WS_MIX), (const bf16*)(q.ws + ((l & 1) ? WS_WOUTT2 : WS_WOUTT)), Mo, 1024, 1024}; pg8::StaticOrder S; S.init(Mo, 1024, nblk, bid);
          EpiOutT<false> E{(const bf16*)q.out, l == 0 ? q.in[I_CTX] : (const float*)(q.ws + WS_CTXS), l == DEPTH - 1 ? (bf16*)(q.ws + WS_HMIX) : (bf16*)q.out, (float*)(q.ws + WS_CTXS), (const float*)(q.ws + WS_MODV) + (size_t)l * 9 * 3072 + 2048};
          pg8::gemm_phase<EpiOutT<false>, pg8::StaticOrder, true, true>((PG8_LAS unsigned char*)smem, g, S, E); }
        xcd_barrier(xbar);
    }
    FENCE(q); ph_final(q, bid, nblk);
#if PROBE
    xcd_barrier(xbar);
    if (bid == 0 && tidx() == 0) q.out[0] = 1000.0f * (float)((unsigned long long*)(q.ws + WS_CTL))[256 + PROBE];
#endif
}

extern "C" void kernel_launch(void* const* d_in, const int* in_sizes, int n_in, void* d_out, int out_size, void* d_ws, size_t ws_size, hipStream_t stream) {
    if (n_in != 31 || ws_size < WS_END) { fprintf(stderr, "kernel_launch: unexpected inputs (n_in %d, ws %zu)\n", n_in, ws_size); return; }
    static int grid_blocks = 0;
    if (!grid_blocks) {
        int dev = 0, cus = 0, per_cu = 0;
        (void)hipGetDevice(&dev);
        (void)hipDeviceGetAttribute(&cus, hipDeviceAttributeMultiprocessorCount, dev);
        (void)hipFuncSetAttribute((const void*)mega, hipFuncAttributeMaxDynamicSharedMemorySize, LDS_BYTES);
        (void)hipOccupancyMaxActiveBlocksPerMultiprocessor(&per_cu, (const void*)mega, NT, LDS_BYTES);
        if (per_cu < 1) { fprintf(stderr, "kernel_launch: occupancy query says %d blocks per CU\n", per_cu); per_cu = 1; }
        grid_blocks = cus;
    }
    KP p{};
    for (int i = 0; i < 31; ++i) p.in[i] = (const float*)d_in[i];
    p.out = (float*)d_out; p.ws = (unsigned char*)d_ws;
    void* args[] = {&p};
    hipError_t e = hipLaunchCooperativeKernel((const void*)mega, dim3(grid_blocks), dim3(NT), args, LDS_BYTES, stream);
    if (e != hipSuccess) fprintf(stderr, "cooperative launch failed: %s (grid %d)\n", hipGetErrorString(e), grid_blocks);
}
```
